# Optimizing an MI355X kernel written in HIP

```python
import math
import jax
import jax.numpy as jnp
from jax import lax
import numpy as np

D_MODEL = 2048
BATCH = 4
SEQ = 4096
DEPTH = 4

GLA_H = 4
GLA_DK = 64
GLA_DV = 128
GLA_GATE_RANK = 16
GLA_GATE_TAU = 16.0
GLA_CHUNK = 16
SSD_DINNER = 512
SSD_HD = 64
SSD_H = SSD_DINNER // SSD_HD
SSD_G = 2
SSD_N = 128
SSD_CONV = 4
SSD_CONV_DIM = SSD_DINNER + 2 * SSD_G * SSD_N
SSD_CHUNK = 64
MLA_H = 4
MLA_NOPE = 128
MLA_ROPE = 64
MLA_QK = MLA_NOPE + MLA_ROPE
MLA_V = 128
MLA_Q_LORA = 384
MLA_KV_LORA = 128
DIL_H = 4
DIL_HD = 128
DIL_CONFIGS = ((128, 1), (512, 4), (2048, 16))
DIL_MAX_W = 2048

Q_BLOCK = 128
ROPE_THETA = 10000.0
EPS = 1e-6
D_MIX = GLA_H * GLA_DV + SSD_DINNER + MLA_H * MLA_V + DIL_H * DIL_HD
IN_WIDTHS = (GLA_H * GLA_DV, SSD_DINNER, MLA_H * MLA_V, DIL_H * DIL_HD,
             GLA_H * GLA_DK, GLA_H * GLA_DK, GLA_H * GLA_DV, GLA_GATE_RANK,
             SSD_CONV_DIM, SSD_H,
             MLA_Q_LORA, MLA_KV_LORA, MLA_ROPE,
             DIL_H * DIL_HD, DIL_H * DIL_HD, DIL_H * DIL_HD)
N_IN = sum(IN_WIDTHS)

kernel_name = 'hybrid_gla_ssd_mla_dilated_parallel_heads'


def _split(u, widths):
    out, start = [], 0
    for w in widths:
        out.append(u[..., start:start + w])
        start += w
    return out


def _rmsnorm(x, g):
    xf = x.astype(jnp.float32)
    y = xf * lax.rsqrt(jnp.mean(xf * xf, axis=-1, keepdims=True) + EPS)
    return (y * g.astype(jnp.float32)).astype(x.dtype)


def _rope(x, pos):
    d = x.shape[-1]
    half = d // 2
    inv_freq = jnp.exp(-math.log(ROPE_THETA) * jnp.arange(half, dtype=jnp.float32) * (2.0 / d))
    ang = pos.astype(jnp.float32)[:, :, None] * inv_freq
    cos = jnp.cos(ang)[:, :, None, :]
    sin = jnp.sin(ang)[:, :, None, :]
    xf = x.astype(jnp.float32)
    x1, x2 = xf[..., :half], xf[..., half:]
    return jnp.concatenate([x1 * cos - x2 * sin, x2 * cos + x1 * sin], axis=-1).astype(x.dtype)


def _gla(q, k, v, log_a, norm_g):
    Bsz, S, H, DK = q.shape
    DV = v.shape[-1]
    C = GLA_CHUNK
    N = S // C

    def chunks(t):
        return t.astype(jnp.float32).reshape(Bsz, N, C, H, t.shape[-1]).transpose(0, 3, 1, 2, 4)

    qc = chunks(q) * (DK ** -0.5)
    kc = chunks(k)
    vc = chunks(v)
    bc = jnp.cumsum(chunks(log_a), axis=3)
    causal = jnp.tril(jnp.ones((C, C), bool))[:, :, None]
    diff = bc[:, :, :, :, None, :] - bc[:, :, :, None, :, :]
    decay = jnp.exp(jnp.where(causal, diff, -jnp.inf))
    attn = jnp.einsum('bhnid,bhnjd,bhnijd->bhnij', qc, kc, decay)
    o_intra = jnp.einsum('bhnij,bhnjv->bhniv', attn, vc)
    b_last = bc[:, :, :, -1, :]
    upd = jnp.einsum('bhncd,bhncv->bhndv', kc * jnp.exp(b_last[:, :, :, None, :] - bc), vc)

    def step(state, inp):
        dec, u = inp
        return state * dec[..., None] + u, state

    init = jnp.zeros((Bsz, H, DK, DV), jnp.float32)
    _, s_before = lax.scan(step, init, (jnp.moveaxis(jnp.exp(b_last), 2, 0), jnp.moveaxis(upd, 2, 0)))
    s_before = jnp.moveaxis(s_before, 0, 2)
    o_inter = jnp.einsum('bhncd,bhndv->bhncv', qc * jnp.exp(bc), s_before)
    o = (o_intra + o_inter).transpose(0, 2, 3, 1, 4).reshape(Bsz, S, H, DV)
    return _rmsnorm(o, norm_g).reshape(Bsz, S, H * DV)


def _segsum(x):
    T = x.shape[-1]
    xe = jnp.broadcast_to(x[..., :, None], x.shape + (T,))
    xe = jnp.where(jnp.tril(jnp.ones((T, T), bool), -1), xe, 0.0)
    ss = jnp.cumsum(xe, axis=-2)
    return jnp.where(jnp.tril(jnp.ones((T, T), bool)), ss, -jnp.inf)


def _ssd_scan(X, A, Bm, Cm):
    b, s, h, p = X.shape
    n = Bm.shape[-1]
    L = SSD_CHUNK
    c = s // L
    Xc = X.reshape(b, c, L, h, p)
    Bc = Bm.reshape(b, c, L, h, n)
    Cc = Cm.reshape(b, c, L, h, n)
    Ac = A.reshape(b, c, L, h).transpose(0, 3, 1, 2)
    A_cs = jnp.cumsum(Ac, axis=-1)
    Lm = jnp.exp(_segsum(Ac))
    y_diag = jnp.einsum('bclhn,bcshn,bhcls,bcshp->bclhp', Cc, Bc, Lm, Xc)
    decay_states = jnp.exp(A_cs[..., -1:] - A_cs)
    states = jnp.einsum('bclhn,bhcl,bclhp->bchpn', Bc, decay_states, Xc)

    def step(st, inp):
        dec, s_new = inp
        return st * dec[:, :, None, None] + s_new, st

    init = jnp.zeros((b, h, p, n), jnp.float32)
    _, prev = lax.scan(step, init, (jnp.moveaxis(jnp.exp(A_cs[..., -1]), 2, 0), jnp.moveaxis(states, 1, 0)))
    prev = jnp.moveaxis(prev, 0, 1)
    y_off = jnp.einsum('bclhn,bchpn,bhcl->bclhp', Cc, prev, jnp.exp(A_cs))
    return (y_diag + y_off).reshape(b, s, h, p)


def _ssd_mixer(xbc, dt_raw, z, conv_w, conv_b, dt_bias, A_log, D, norm_g):
    Bsz, S, _ = xbc.shape
    xpad = jnp.pad(xbc.astype(jnp.float32), ((0, 0), (SSD_CONV - 1, 0), (0, 0)))
    conv = jnp.broadcast_to(conv_b.astype(jnp.float32), (Bsz, S, SSD_CONV_DIM))
    for j in range(SSD_CONV):
        conv = conv + xpad[:, j:j + S, :] * conv_w[j].astype(jnp.float32)
    xbc = jax.nn.silu(conv)
    xs, Bm, Cm = _split(xbc, (SSD_DINNER, SSD_G * SSD_N, SSD_G * SSD_N))
    xs = xs.reshape(Bsz, S, SSD_H, SSD_HD)
    Bm = jnp.repeat(Bm.reshape(Bsz, S, SSD_G, SSD_N), SSD_H // SSD_G, axis=2)
    Cm = jnp.repeat(Cm.reshape(Bsz, S, SSD_G, SSD_N), SSD_H // SSD_G, axis=2)
    dt = jax.nn.softplus(dt_raw.astype(jnp.float32) + dt_bias.astype(jnp.float32))
    A = -jnp.exp(A_log.astype(jnp.float32))
    y = _ssd_scan(xs * dt[..., None], dt * A, Bm, Cm) + xs * D.astype(jnp.float32)[:, None]
    y = y.reshape(Bsz, S, SSD_DINNER) * jax.nn.silu(z.astype(jnp.float32))
    y = _rmsnorm(y.reshape(Bsz, S, SSD_G, SSD_DINNER // SSD_G), norm_g.reshape(SSD_G, SSD_DINNER // SSD_G))
    return y.reshape(Bsz, S, SSD_DINNER)


def _causal_attention(q, k, v):
    Bsz, S, H, dq = q.shape
    nb = S // Q_BLOCK
    scale = dq ** -0.5
    qb = q.reshape(Bsz, nb, Q_BLOCK, H, dq).transpose(1, 0, 2, 3, 4)
    kpos = jnp.arange(S)

    def one(args):
        qi, i = args
        s = jnp.einsum('bqhd,bkhd->bhqk', qi, k, preferred_element_type=jnp.float32) * scale
        qpos = i * Q_BLOCK + jnp.arange(Q_BLOCK)
        s = jnp.where(kpos[None, :] <= qpos[:, None], s, -jnp.inf)
        p = jax.nn.softmax(s, axis=-1)
        return jnp.einsum('bhqk,bkhd->bqhd', p.astype(v.dtype), v)

    o = lax.map(one, (qb, jnp.arange(nb)))
    return o.transpose(1, 0, 2, 3, 4).reshape(Bsz, S, H, v.shape[-1])


def _mla(c_q, c_kv, k_rope, positions, q_norm_g, kv_norm_g, w_uq, w_ukv, q_head_g, k_head_g):
    Bsz, S, _ = c_q.shape
    q = (_rmsnorm(c_q, q_norm_g) @ w_uq).reshape(Bsz, S, MLA_H, MLA_QK)
    kv = (_rmsnorm(c_kv, kv_norm_g) @ w_ukv).reshape(Bsz, S, MLA_H, MLA_NOPE + MLA_V)
    k_nope, v = kv[..., :MLA_NOPE], kv[..., MLA_NOPE:]
    k_r = jnp.broadcast_to(k_rope[:, :, None, :], (Bsz, S, MLA_H, MLA_ROPE))
    k = _rmsnorm(jnp.concatenate([k_nope, k_r], axis=-1), k_head_g)
    q = _rmsnorm(q, q_head_g)
    q = jnp.concatenate([q[..., :MLA_NOPE], _rope(q[..., MLA_NOPE:], positions)], axis=-1)
    k = jnp.concatenate([k[..., :MLA_NOPE], _rope(k[..., MLA_NOPE:], positions)], axis=-1)
    return _causal_attention(q, k, v).reshape(Bsz, S, MLA_H * MLA_V)


def _dilated_attention(q, k, v):
    Bsz, S, H, Dh = q.shape
    nb = S // Q_BLOCK
    scale = Dh ** -0.5
    pad = ((0, 0), (DIL_MAX_W, 0), (0, 0), (0, 0))
    kp = jnp.pad(k, pad)
    vp = jnp.pad(v, pad)
    qb = q.reshape(Bsz, nb, Q_BLOCK, H, Dh).transpose(1, 0, 2, 3, 4)
    rows = np.arange(Q_BLOCK)

    def one(args):
        qi, i = args
        t0 = i * Q_BLOCK
        scores, vals, sizes = [], [], []
        for (w, d) in DIL_CONFIGS:
            taps = np.arange(w // d + 1)
            idx = rows[:, None] + w - taps[None, :] * d
            start = t0 + DIL_MAX_W - w
            ks = lax.dynamic_slice_in_dim(kp, start, Q_BLOCK + w, axis=1)
            vs = lax.dynamic_slice_in_dim(vp, start, Q_BLOCK + w, axis=1)
            kg = jnp.take(ks, idx, axis=1)
            s = jnp.einsum('bqhd,bqjhd->bhqj', qi, kg, preferred_element_type=jnp.float32) * scale
            valid = (t0 + rows[:, None] - taps[None, :] * d) >= 0
            scores.append(jnp.where(valid, s, -jnp.inf))
            vals.append(jnp.take(vs, idx, axis=1))
            sizes.append(taps.shape[0])
        p = jax.nn.softmax(jnp.concatenate(scores, axis=-1), axis=-1)
        out = None
        for p_c, v_c in zip(_split(p, sizes), vals):
            o_c = jnp.einsum('bhqj,bqjhd->bqhd', p_c.astype(v_c.dtype), v_c)
            out = o_c if out is None else out + o_c
        return out

    o = lax.map(one, (qb, jnp.arange(nb)))
    return o.transpose(1, 0, 2, 3, 4).reshape(Bsz, S, H * Dh)


def setup_inputs(seed: int = 0) -> dict:
    key = jax.random.key(seed)
    ks = jax.random.split(key, 24)

    def nrm(k, shape, scale):
        return jax.random.normal(k, shape, jnp.float32) * scale

    def gain(k, n):
        return 1.0 + nrm(k, (DEPTH, n), 0.02)

    x = nrm(ks[0], (BATCH, SEQ, D_MODEL), 1.0)
    offs = jax.random.randint(ks[1], (BATCH, 1), 0, SEQ, dtype=jnp.int32)
    positions = offs + jnp.arange(SEQ, dtype=jnp.int32)[None, :]
    dt0 = jnp.exp(jax.random.uniform(ks[2], (DEPTH, SSD_H), jnp.float32, math.log(1e-3), math.log(1e-1)))
    return {
        'x': x,
        'positions': positions,
        'ln_g': gain(ks[3], D_MODEL),
        'w_in': nrm(ks[4], (DEPTH, D_MODEL, N_IN), D_MODEL ** -0.5),
        'w_out': nrm(ks[5], (DEPTH, D_MIX, D_MODEL), D_MIX ** -0.5),
        'gla_gate_w2': nrm(ks[6], (DEPTH, GLA_GATE_RANK, GLA_H * GLA_DK), GLA_GATE_RANK ** -0.5),
        'gla_gate_b': nrm(ks[7], (DEPTH, GLA_H * GLA_DK), 0.1),
        'gla_norm_g': gain(ks[8], GLA_DV),
        'ssd_conv_w': nrm(ks[9], (DEPTH, SSD_CONV, SSD_CONV_DIM), SSD_CONV ** -0.5),
        'ssd_conv_b': nrm(ks[10], (DEPTH, SSD_CONV_DIM), 0.02),
        'ssd_dt_bias': dt0 + jnp.log(-jnp.expm1(-dt0)),
        'ssd_A_log': jnp.log(jax.random.uniform(ks[11], (DEPTH, SSD_H), jnp.float32, 1.0, 16.0)),
        'ssd_D': 1.0 + nrm(ks[12], (DEPTH, SSD_H), 0.1),
        'ssd_norm_g': gain(ks[13], SSD_DINNER),
        'mla_q_norm_g': gain(ks[14], MLA_Q_LORA),
        'mla_kv_norm_g': gain(ks[15], MLA_KV_LORA),
        'mla_w_uq': nrm(ks[16], (DEPTH, MLA_Q_LORA, MLA_H * MLA_QK), MLA_Q_LORA ** -0.5),
        'mla_w_ukv': nrm(ks[17], (DEPTH, MLA_KV_LORA, MLA_H * (MLA_NOPE + MLA_V)), MLA_KV_LORA ** -0.5),
        'mla_q_head_g': gain(ks[18], MLA_QK),
        'mla_k_head_g': gain(ks[19], MLA_QK),
        'dil_q_g': gain(ks[20], DIL_HD),
        'dil_k_g': gain(ks[21], DIL_HD),
    }


def reference(x, positions, ln_g, w_in, w_out, gla_gate_w2, gla_gate_b, gla_norm_g,
              ssd_conv_w, ssd_conv_b, ssd_dt_bias, ssd_A_log, ssd_D, ssd_norm_g,
              mla_q_norm_g, mla_kv_norm_g, mla_w_uq, mla_w_ukv, mla_q_head_g, mla_k_head_g,
              dil_q_g, dil_k_g):
    Bsz, S, _ = x.shape
    for l in range(DEPTH):
        h = _rmsnorm(x, ln_g[l])
        u = h @ w_in[l]
        (g_a, g_b, g_c, g_d, a_q, a_k, a_v, a_lr, b_xbc, b_dt,
         c_q, c_kv, c_kr, d_q, d_k, d_v) = _split(u, IN_WIDTHS)
        log_a = jax.nn.log_sigmoid((a_lr @ gla_gate_w2[l] + gla_gate_b[l]).astype(jnp.float32)) / GLA_GATE_TAU
        y_a = _gla(a_q.reshape(Bsz, S, GLA_H, GLA_DK), a_k.reshape(Bsz, S, GLA_H, GLA_DK),
                   a_v.reshape(Bsz, S, GLA_H, GLA_DV), log_a.reshape(Bsz, S, GLA_H, GLA_DK),
                   gla_norm_g[l]) * jax.nn.silu(g_a)
        y_b = _ssd_mixer(b_xbc, b_dt, g_b, ssd_conv_w[l], ssd_conv_b[l], ssd_dt_bias[l],
                         ssd_A_log[l], ssd_D[l], ssd_norm_g[l])
        y_c = _mla(c_q, c_kv, c_kr, positions, mla_q_norm_g[l], mla_kv_norm_g[l], mla_w_uq[l],
                   mla_w_ukv[l], mla_q_head_g[l], mla_k_head_g[l]) * jax.nn.silu(g_c)
        dq = _rope(_rmsnorm(d_q.reshape(Bsz, S, DIL_H, DIL_HD), dil_q_g[l]), positions)
        dk = _rope(_rmsnorm(d_k.reshape(Bsz, S, DIL_H, DIL_HD), dil_k_g[l]), positions)
        y_d = _dilated_attention(dq, dk, d_v.reshape(Bsz, S, DIL_H, DIL_HD)) * jax.nn.silu(g_d)
        y = jnp.concatenate([y_a, y_b, y_c, y_d], axis=-1).astype(x.dtype)
        x = x + y @ w_out[l]
    return x
```

```cpp
#include <hip/hip_runtime.h>
#include <hip/hip_cooperative_groups.h>
#include <cstdio>
#include <cstdint>
namespace cg = cooperative_groups;
#ifndef MK_MULTI
#define MK_MULTI 1
#endif
namespace pg8 {
#define PG8_LAS __attribute__((address_space(3)))
typedef unsigned short bf16_t;
typedef short bf16x8 __attribute__((ext_vector_type(8)));
typedef float f32x4 __attribute__((ext_vector_type(4)));
typedef unsigned u32x4 __attribute__((ext_vector_type(4)));
constexpr int BM = 256, BK = 64, HALF = 128, HTB = HALF * BK * 2  , STAGE_BYTES = 8 * HTB, NXCD = 8, WGM = 8;

__host__ __device__ __forceinline__ int lds_byte(int r, int c) { const int st = (r >> 4) * 2 + (c >> 5), rr = r & 15, cc = c & 31, ob = rr * 64 + cc * 2; return st * 1024 + (ob ^ (((ob >> 9) & 1) << 5)); }
__host__ __device__ __forceinline__ void stage_rc(int b, int& R, int& C) { const int st = b / 1024, sb = b % 1024, swz = sb ^ (((sb >> 9) & 1) << 5); R = (st >> 1) * 16 + swz / 64; C = (st & 1) * 32 + (swz % 64) / 2; }
__host__ __device__ __forceinline__ int perm32(int rho) { const int n = rho >> 4, i = rho & 15; return 8 * (i >> 2) + 4 * n + (i & 3); }

struct Unit { int pm, pn; };
struct Gemm { const bf16_t* A; const bf16_t* Bt; int M, N, K; };

struct StaticOrder {
    int nM, nN, nwg, G, c;
    __host__ __device__ void init(int M, int N, int G_, int c_) { nM = M / BM; nN = N / BM; nwg = nM * nN; G = G_; c = c_; }
    __host__ __device__ bool next(int i, Unit& u) const {
        const long L = (long)i * G + c; if (L >= nwg) return false;
        int wgid = (int)L; { const int q = nwg / NXCD, r = nwg % NXCD, xcd = wgid % NXCD, off = wgid / NXCD; wgid = (xcd < r ? xcd * (q + 1) : r * (q + 1) + (xcd - r) * q) + off; }
        const int nig = WGM * nN, gid = wgid / nig, fm = gid * WGM, gsz = (nM - fm) < WGM ? (nM - fm) : WGM;
        u.pm = fm + ((wgid % nig) % gsz); u.pn = (wgid % nig) / gsz; return true;
    }
    __device__ __forceinline__ void a_ready(const Unit&) const {}
    __device__ __forceinline__ void done(const Unit&) const {}
};
template <class Epi, class Sched>
__device__ __forceinline__ void gemm_phase(PG8_LAS unsigned char* lds, const Gemm g, const Sched& S, const Epi& E) {
    int tid_ = threadIdx.x; asm volatile("" : "+v"(tid_));
    const int tid = tid_, wid = __builtin_amdgcn_readfirstlane(tid >> 6), lane = tid & 63, wr = wid >> 2, wc = wid & 3, fr = lane & 15, fq = lane >> 4;
    const int K = g.K, nt = K / BK;
    unsigned voffA[2], voffB[2];
#pragma unroll
    for (int i = 0; i < 2; ++i) { int R, C; stage_rc(tid * 16 + i * 8192, R, C); const int Rb = Epi::PERM ? ((R & ~31) + perm32(R & 31)) : R;
        voffA[i] = (unsigned)(R * K + C) * 2u; voffB[i] = (unsigned)(Rb * K + C) * 2u; }
    const size_t kstep = (size_t)(BK * 2);
    const size_t hstep = (size_t)HALF * K * 2;
    const size_t tstep = 2 * hstep;
    const unsigned ldsw = (unsigned)wid * 1024u;
    const int aoff = lds_byte(wr * 64 + fr, fq * 8), boff = lds_byte(wc * 32 + fr, fq * 8);
#define PG8_SA(b, h) (((b) * 2 + (h)) * HTB)
#define PG8_SB(b, h) ((4 + (b) * 2 + (h)) * HTB)
#define PG8_STAGE(bufoff, gbase, voff) do { _Pragma("unroll") for (int _i = 0; _i < 2; ++_i) \
        __builtin_amdgcn_global_load_lds((const unsigned*)((const char*)(gbase) + (voff)[_i]), (PG8_LAS unsigned*)(lds + (bufoff) + ldsw + _i * 8192), 16, 0, 0); } while (0)
#define PG8_LDA(dst, b, h) do { _Pragma("unroll") for (int m = 0; m < 4; ++m) _Pragma("unroll") for (int k = 0; k < 2; ++k) dst[m][k] = *(const PG8_LAS bf16x8*)(lds + PG8_SA(b, h) + aoff + m * 2048 + k * 1024); } while (0)
#define PG8_LDB(dst, b, h) do { _Pragma("unroll") for (int n = 0; n < 2; ++n) _Pragma("unroll") for (int k = 0; k < 2; ++k) dst[n][k] = *(const PG8_LAS bf16x8*)(lds + PG8_SB(b, h) + boff + n * 2048 + k * 1024); } while (0)
#define PG8_MMA(ai, bj, At, Bt) do { __builtin_amdgcn_s_setprio(1); _Pragma("unroll") for (int m = 0; m < 4; ++m) _Pragma("unroll") for (int n = 0; n < 2; ++n) _Pragma("unroll") for (int k = 0; k < 2; ++k) \
        acc[ai][bj][m][n] = __builtin_amdgcn_mfma_f32_16x16x32_bf16(Bt[n][k], At[m][k], acc[ai][bj][m][n], 0, 0, 0); __builtin_amdgcn_s_setprio(0); } while (0)
#define PG8_WAIT_V(n) asm volatile("s_waitcnt vmcnt(" #n ")" ::: "memory")
#define PG8_WAIT_L(n) asm volatile("s_waitcnt lgkmcnt(" #n ")" ::: "memory")
#define PG8_BAR __builtin_amdgcn_s_barrier()
#define PG8_SCHED __builtin_amdgcn_sched_barrier(0)
    Unit cur, nxt; int ui = 0;
    if (!S.next(0, cur)) return;
    f32x4 acc[2][2][4][2];
#pragma unroll
    for (int a = 0; a < 2; ++a)
#pragma unroll
        for (int b = 0; b < 2; ++b)
#pragma unroll
            for (int m = 0; m < 4; ++m)
#pragma unroll
                for (int n = 0; n < 2; ++n) acc[a][b][m][n] = (f32x4){0.f, 0.f, 0.f, 0.f};
    bf16x8 At[4][2], B0[2][2], B1[2][2];
    const char* cA = (const char*)g.A + (size_t)cur.pm * tstep; const char* cB = (const char*)g.Bt + (size_t)cur.pn * tstep;
    S.a_ready(cur);
    PG8_STAGE(PG8_SB(0, 0), cB, voffB); PG8_STAGE(PG8_SA(0, 0), cA, voffA); PG8_STAGE(PG8_SB(0, 1), cB + hstep, voffB); PG8_STAGE(PG8_SA(0, 1), cA + hstep, voffA);
    if (wr == 1) PG8_BAR;
    PG8_WAIT_V(4); PG8_BAR;
    PG8_STAGE(PG8_SB(1, 0), cB + kstep, voffB); PG8_STAGE(PG8_SA(1, 0), cA + kstep, voffA); PG8_STAGE(PG8_SB(1, 1), cB + hstep + kstep, voffB);
    PG8_WAIT_V(6); PG8_BAR;
    for (;;) {
        const bool has_next = S.next(ui + 1, nxt);
        const char* nA = has_next ? (const char*)g.A + (size_t)nxt.pm * tstep : cA; const char* nB = has_next ? (const char*)g.Bt + (size_t)nxt.pn * tstep : cB;
        for (int t = 0; t < nt; t += 2) {
            const bool last = (t == nt - 2);
            const char* a1 = cA + (size_t)(t + 1) * kstep;
            const char* a2 = last ? nA : cA + (size_t)(t + 2) * kstep; const char* b2 = last ? nB : cB + (size_t)(t + 2) * kstep;
            const char* a3 = a2 + kstep; const char* b3 = b2 + kstep;
            if (last && has_next) S.a_ready(nxt);
            PG8_LDB(B0, 0, 0); PG8_SCHED; PG8_LDA(At, 0, 0); PG8_STAGE(PG8_SA(1, 1), a1 + hstep, voffA);
            PG8_WAIT_L(8); PG8_BAR; PG8_WAIT_L(0); PG8_MMA(0, 0, At, B0); PG8_BAR; PG8_SCHED;
            PG8_LDB(B1, 0, 1); PG8_STAGE(PG8_SB(0, 0), b2, voffB);
            PG8_BAR; PG8_WAIT_L(0); PG8_MMA(0, 1, At, B1); PG8_BAR;
            PG8_LDA(At, 0, 1); PG8_STAGE(PG8_SA(0, 0), a2, voffA);
            PG8_BAR; PG8_WAIT_L(0); PG8_MMA(1, 0, At, B0); PG8_BAR; PG8_SCHED;
            PG8_STAGE(PG8_SB(0, 1), b2 + hstep, voffB);
            PG8_WAIT_V(6); PG8_BAR; PG8_MMA(1, 1, At, B1); PG8_BAR;
            PG8_LDB(B0, 1, 0); PG8_SCHED; PG8_LDA(At, 1, 0); PG8_STAGE(PG8_SA(0, 1), a2 + hstep, voffA);
            PG8_WAIT_L(8); PG8_BAR; PG8_WAIT_L(0); PG8_MMA(0, 0, At, B0); PG8_BAR; PG8_SCHED;
            PG8_LDB(B1, 1, 1); PG8_STAGE(PG8_SB(1, 0), b3, voffB);
            PG8_BAR; PG8_WAIT_L(0); PG8_MMA(0, 1, At, B1); PG8_BAR;
            PG8_LDA(At, 1, 1); PG8_STAGE(PG8_SA(1, 0), a3, voffA);
            PG8_BAR; PG8_WAIT_L(0); PG8_MMA(1, 0, At, B0); PG8_BAR; PG8_SCHED;
            PG8_STAGE(PG8_SB(1, 1), b3 + hstep, voffB);
            PG8_WAIT_V(6); PG8_BAR; PG8_MMA(1, 1, At, B1); PG8_BAR;
        }
        if constexpr (!Epi::AFTER_DRAIN) { E(acc, cur, wr, wc, fr, fq); S.done(cur); }
        if (!has_next) break;
#pragma unroll
        for (int a = 0; a < 2; ++a)
#pragma unroll
            for (int b = 0; b < 2; ++b)
#pragma unroll
                for (int m = 0; m < 4; ++m)
#pragma unroll
                    for (int n = 0; n < 2; ++n) acc[a][b][m][n] = (f32x4){0.f, 0.f, 0.f, 0.f};
        cur = nxt; cA = nA; cB = nB; ++ui;
    }
    PG8_WAIT_V(0);
    if (wr == 0) PG8_BAR;
    PG8_BAR;
    if constexpr (Epi::AFTER_DRAIN) { E.fused(acc, cur, wr, wc, fr, fq, lds, wid, lane); S.done(cur); }
#undef PG8_SA
#undef PG8_SB
#undef PG8_STAGE
#undef PG8_LDA
#undef PG8_LDB
#undef PG8_MMA
#undef PG8_WAIT_V
#undef PG8_WAIT_L
#undef PG8_BAR
#undef PG8_SCHED
}
}

#define DI __device__ __forceinline__
using pg8::bf16_t; using pg8::bf16x8; using pg8::f32x4; using pg8::u32x4;
typedef short s16x4 __attribute__((ext_vector_type(4)));
typedef unsigned u32x2 __attribute__((ext_vector_type(2)));
typedef __bf16 bf16v2 __attribute__((ext_vector_type(2)));
constexpr int T_ = 16384, S_ = 4096, NINP = 6400, NIN = 6232, NLAYER = 4;
constexpr int U_GA = 0, U_GB = 512, U_GC = 1024, U_GD = 1536, U_AQ = 2048, U_AK = 2304, U_AV = 2560, U_ALR = 3072,
              U_XBC = 3088, U_DT = 4112, U_CQ = 4120, U_CKV = 4504, U_CKR = 4632, U_DQ = 4696, U_DK = 5208, U_DV = 5720;
constexpr float EPS_ = 1e-6f, LOG2E = 1.4426950408889634f;
constexpr int LDS_BYTES = 131072;
constexpr int P3_NITEMS = 16 + 16 + 512 + 512;

constexpr size_t SZ_WinT = (size_t)(NLAYER*(size_t)NINP*(size_t)2048*(size_t)2), OFF_WinT = 0;
constexpr size_t SZ_WoutT = (size_t)(NLAYER*(size_t)2048*(size_t)2048*(size_t)2), OFF_WoutT = OFF_WinT + ((SZ_WinT + 255) & ~(size_t)255);
constexpr size_t SZ_WuqT = (size_t)(NLAYER*(size_t)768*(size_t)384*(size_t)2), OFF_WuqT = OFF_WoutT + ((SZ_WoutT + 255) & ~(size_t)255);
constexpr size_t SZ_WukvT = (size_t)(NLAYER*(size_t)1024*(size_t)128*(size_t)2), OFF_WukvT = OFF_WuqT + ((SZ_WuqT + 255) & ~(size_t)255);
constexpr size_t SZ_u = (size_t)(T_*(size_t)NINP*(size_t)2), OFF_u = OFF_WukvT + ((SZ_WukvT + 255) & ~(size_t)255);
constexpr size_t SZ_y = (size_t)(T_*(size_t)2048*(size_t)2), OFF_y = OFF_u + ((SZ_u + 255) & ~(size_t)255);
constexpr size_t SZ_rowsq = (size_t)(T_*(size_t)32*(size_t)4), OFF_rowsq = OFF_y + ((SZ_y + 255) & ~(size_t)255);
constexpr size_t SZ_cosM = (size_t)(T_*(size_t)32*(size_t)4), OFF_cosM = OFF_rowsq + ((SZ_rowsq + 255) & ~(size_t)255);
constexpr size_t SZ_sinM = (size_t)(T_*(size_t)32*(size_t)4), OFF_sinM = OFF_cosM + ((SZ_cosM + 255) & ~(size_t)255);
constexpr size_t SZ_cosD = (size_t)(T_*(size_t)64*(size_t)4), OFF_cosD = OFF_sinM + ((SZ_sinM + 255) & ~(size_t)255);
constexpr size_t SZ_sinD = (size_t)(T_*(size_t)64*(size_t)4), OFF_sinD = OFF_cosD + ((SZ_cosD + 255) & ~(size_t)255);
constexpr size_t SZ_Qe = (size_t)(T_*(size_t)256*(size_t)2), OFF_Qe = OFF_sinD + ((SZ_sinD + 255) & ~(size_t)255);
constexpr size_t SZ_KdT = (size_t)(T_*(size_t)256*(size_t)2), OFF_KdT = OFF_Qe + ((SZ_Qe + 255) & ~(size_t)255);
constexpr size_t SZ_gvT = (size_t)(T_*(size_t)512*(size_t)2), OFF_gvT = OFF_KdT + ((SZ_KdT + 255) & ~(size_t)255);
constexpr size_t SZ_dec = (size_t)((T_/16)*(size_t)256*(size_t)4), OFF_dec = OFF_gvT + ((SZ_gvT + 255) & ~(size_t)255);
constexpr size_t SZ_ogla = (size_t)(T_*(size_t)512*(size_t)4), OFF_ogla = OFF_dec + ((SZ_dec + 255) & ~(size_t)255);
constexpr size_t SZ_yssd = (size_t)(T_*(size_t)512*(size_t)4), OFF_yssd = OFF_ogla + ((SZ_ogla + 255) & ~(size_t)255);
constexpr size_t SZ_xs = (size_t)(T_*(size_t)512*(size_t)2), OFF_xs = OFF_yssd + ((SZ_yssd + 255) & ~(size_t)255);
constexpr size_t SZ_Bm = (size_t)(T_*(size_t)256*(size_t)2), OFF_Bm = OFF_xs + ((SZ_xs + 255) & ~(size_t)255);
constexpr size_t SZ_Cm = (size_t)(T_*(size_t)256*(size_t)2), OFF_Cm = OFF_Bm + ((SZ_Bm + 255) & ~(size_t)255);
constexpr size_t SZ_BmT = (size_t)(T_*(size_t)256*(size_t)2), OFF_BmT = OFF_Cm + ((SZ_Cm + 255) & ~(size_t)255);
constexpr size_t SZ_XdT = (size_t)(T_*(size_t)512*(size_t)2), OFF_XdT = OFF_BmT + ((SZ_BmT + 255) & ~(size_t)255);
constexpr size_t SZ_XdtT = (size_t)(T_*(size_t)512*(size_t)2), OFF_XdtT = OFF_XdT + ((SZ_XdT + 255) & ~(size_t)255);
constexpr size_t SZ_Acs = (size_t)(T_*(size_t)8*(size_t)4), OFF_Acs = OFF_XdtT + ((SZ_XdtT + 255) & ~(size_t)255);
constexpr size_t SZ_Qc = (size_t)(T_*(size_t)768*(size_t)2), OFF_Qc = OFF_Acs + ((SZ_Acs + 255) & ~(size_t)255);
constexpr size_t SZ_Kc = (size_t)(T_*(size_t)768*(size_t)2), OFF_Kc = OFF_Qc + ((SZ_Qc + 255) & ~(size_t)255);
constexpr size_t SZ_Vct = (size_t)(T_*(size_t)512*(size_t)2), OFF_Vct = OFF_Kc + ((SZ_Kc + 255) & ~(size_t)255);
constexpr size_t SZ_dq = (size_t)(T_*(size_t)512*(size_t)2), OFF_dq = OFF_Vct + ((SZ_Vct + 255) & ~(size_t)255);
constexpr size_t SZ_dk = (size_t)(T_*(size_t)512*(size_t)2), OFF_dk = OFF_dq + ((SZ_dq + 255) & ~(size_t)255);
constexpr size_t SZ_Vt1 = (size_t)(T_*(size_t)512*(size_t)2), OFF_Vt1 = OFF_dk + ((SZ_dk + 255) & ~(size_t)255);
constexpr size_t SZ_Vt4 = (size_t)(T_*(size_t)512*(size_t)2), OFF_Vt4 = OFF_Vt1 + ((SZ_Vt1 + 255) & ~(size_t)255);
constexpr size_t SZ_Vt16 = (size_t)(T_*(size_t)512*(size_t)2), OFF_Vt16 = OFF_Vt4 + ((SZ_Vt4 + 255) & ~(size_t)255);
constexpr size_t SZ_ctr = (size_t)(256), OFF_ctr = OFF_Vt16 + ((SZ_Vt16 + 255) & ~(size_t)255);
constexpr size_t WS_TOTAL = OFF_ctr + ((SZ_ctr + 255) & ~(size_t)255);
struct Params {
    const float *x, *ln_g, *w_in, *w_out, *gw2, *gb, *gng, *cw, *cb, *dtb, *alog, *sD, *sng, *qng, *kvng, *wuq, *wukv, *qhg, *khg, *dqg, *dkg;
    const int* pos;
    float* out;
    unsigned char* ws;
    int ph_lo, ph_hi;
    __device__ __forceinline__ bf16_t* WinT() const { return (bf16_t*)(ws + OFF_WinT); }
    __device__ __forceinline__ bf16_t* WoutT() const { return (bf16_t*)(ws + OFF_WoutT); }
    __device__ __forceinline__ bf16_t* WuqT() const { return (bf16_t*)(ws + OFF_WuqT); }
    __device__ __forceinline__ bf16_t* WukvT() const { return (bf16_t*)(ws + OFF_WukvT); }
    __device__ __forceinline__ bf16_t* u() const { return (bf16_t*)(ws + OFF_u); }
    __device__ __forceinline__ bf16_t* y() const { return (bf16_t*)(ws + OFF_y); }
    __device__ __forceinline__ float* rowsq() const { return (float*)(ws + OFF_rowsq); }
    __device__ __forceinline__ float* cosM() const { return (float*)(ws + OFF_cosM); }
    __device__ __forceinline__ float* sinM() const { return (float*)(ws + OFF_sinM); }
    __device__ __forceinline__ float* cosD() const { return (float*)(ws + OFF_cosD); }
    __device__ __forceinline__ float* sinD() const { return (float*)(ws + OFF_sinD); }
    __device__ __forceinline__ bf16_t* Qe() const { return (bf16_t*)(ws + OFF_Qe); }
    __device__ __forceinline__ bf16_t* KdT() const { return (bf16_t*)(ws + OFF_KdT); }
    __device__ __forceinline__ bf16_t* gvT() const { return (bf16_t*)(ws + OFF_gvT); }
    __device__ __forceinline__ float* dec() const { return (float*)(ws + OFF_dec); }
    __device__ __forceinline__ float* ogla() const { return (float*)(ws + OFF_ogla); }
    __device__ __forceinline__ float* yssd() const { return (float*)(ws + OFF_yssd); }
    __device__ __forceinline__ bf16_t* xs() const { return (bf16_t*)(ws + OFF_xs); }
    __device__ __forceinline__ bf16_t* Bm() const { return (bf16_t*)(ws + OFF_Bm); }
    __device__ __forceinline__ bf16_t* Cm() const { return (bf16_t*)(ws + OFF_Cm); }
    __device__ __forceinline__ bf16_t* BmT() const { return (bf16_t*)(ws + OFF_BmT); }
    __device__ __forceinline__ bf16_t* XdT() const { return (bf16_t*)(ws + OFF_XdT); }
    __device__ __forceinline__ bf16_t* XdtT() const { return (bf16_t*)(ws + OFF_XdtT); }
    __device__ __forceinline__ float* Acs() const { return (float*)(ws + OFF_Acs); }
    __device__ __forceinline__ bf16_t* Qc() const { return (bf16_t*)(ws + OFF_Qc); }
    __device__ __forceinline__ bf16_t* Kc() const { return (bf16_t*)(ws + OFF_Kc); }
    __device__ __forceinline__ bf16_t* Vct() const { return (bf16_t*)(ws + OFF_Vct); }
    __device__ __forceinline__ bf16_t* dq() const { return (bf16_t*)(ws + OFF_dq); }
    __device__ __forceinline__ bf16_t* dk() const { return (bf16_t*)(ws + OFF_dk); }
    __device__ __forceinline__ bf16_t* Vt1() const { return (bf16_t*)(ws + OFF_Vt1); }
    __device__ __forceinline__ bf16_t* Vt4() const { return (bf16_t*)(ws + OFF_Vt4); }
    __device__ __forceinline__ bf16_t* Vt16() const { return (bf16_t*)(ws + OFF_Vt16); }
    __device__ __forceinline__ unsigned* ctr() const { return (unsigned*)(ws + OFF_ctr); }
    __device__ __forceinline__ bf16_t* xb() const { return (bf16_t*)(ws + OFF_ogla); }
};

DI int tidl() { int t = threadIdx.x; asm volatile("" : "+v"(t)); return t; }
DI float bf2f(bf16_t h) { return __uint_as_float((unsigned)h << 16); }
DI unsigned pk2(float lo, float hi) { bf16v2 v = {(__bf16)lo, (__bf16)hi}; return __builtin_bit_cast(unsigned, v); }
DI bf16_t f2bf(float x) { return (bf16_t)(pk2(x, 0.f) & 0xffffu); }
DI float lo2f(unsigned w) { return __uint_as_float(w << 16); }
DI float hi2f(unsigned w) { return __uint_as_float(w & 0xffff0000u); }
DI float wsum(float v) {
#pragma unroll
    for (int o = 32; o; o >>= 1) v += __shfl_xor(v, o);
    return v; }
DI float wmaxf(float v) {
#pragma unroll
    for (int o = 32; o; o >>= 1) v = fmaxf(v, __shfl_xor(v, o));
    return v; }
DI float silu_f(float x) { return x / (1.f + __expf(-x)); }
DI bf16x8 pack8(f32x4 a, f32x4 b) { u32x4 w; w.x = pk2(a[0], a[1]); w.y = pk2(a[2], a[3]); w.z = pk2(b[0], b[1]); w.w = pk2(b[2], b[3]); return __builtin_bit_cast(bf16x8, w); }
DI bf16x8 cat4(s16x4 a, s16x4 b) { bf16x8 r; r[0] = a[0]; r[1] = a[1]; r[2] = a[2]; r[3] = a[3]; r[4] = b[0]; r[5] = b[1]; r[6] = b[2]; r[7] = b[3]; return r; }
DI bf16x8 zero8() { bf16x8 r = {0, 0, 0, 0, 0, 0, 0, 0}; return r; }
DI s16x4 zero4() { s16x4 r = {0, 0, 0, 0}; return r; }
DI f32x4 fz4() { f32x4 r = {0.f, 0.f, 0.f, 0.f}; return r; }
DI f32x4 mfma16(bf16x8 a, bf16x8 b, f32x4 c) { return __builtin_amdgcn_mfma_f32_16x16x32_bf16(a, b, c, 0, 0, 0); }
DI bf16x8 ldperm(const bf16_t* p, int fq) { return cat4(*(const s16x4*)(p + 4 * fq), *(const s16x4*)(p + 16 + 4 * fq)); }
DI f32x4 ld4bf(const bf16_t* p) { u32x2 w = *(const u32x2*)p; f32x4 r; r[0] = lo2f(w.x); r[1] = hi2f(w.x); r[2] = lo2f(w.y); r[3] = hi2f(w.y); return r; }
DI void st4bf(bf16_t* p, f32x4 v) { u32x2 w; w.x = pk2(v[0], v[1]); w.y = pk2(v[2], v[3]); *(u32x2*)p = w; }

struct EpiIn {
    static constexpr bool PERM = true, AFTER_DRAIN = false;
    bf16_t* U; const float* rowsq;
    DI void operator()(const f32x4 (&acc)[2][2][4][2], const pg8::Unit& u, int wr, int wc, int fr, int fq) const {
        const int row0 = u.pm * 256 + wr * 64 + fr, col0 = u.pn * 256 + wc * 32 + 8 * fq;
#pragma unroll
        for (int ai = 0; ai < 2; ++ai)
#pragma unroll
            for (int m = 0; m < 4; ++m) {
                const int row = row0 + ai * 128 + m * 16;
                f32x4 pa = *(const f32x4*)(rowsq + (size_t)row * 32);
#pragma unroll
                for (int k = 1; k < 8; ++k) pa += *(const f32x4*)(rowsq + (size_t)row * 32 + 4 * k);
                const float rs = rsqrtf(((pa[0] + pa[1]) + (pa[2] + pa[3])) * (1.0f / 2048.0f) + EPS_);
                bf16_t* rowp = U + (size_t)row * NINP + col0;
#pragma unroll
                for (int bj = 0; bj < 2; ++bj) {
                    const f32x4 v0 = acc[ai][bj][m][0] * rs, v1 = acc[ai][bj][m][1] * rs;
                    u32x4 w; w.x = pk2(v0[0], v0[1]); w.y = pk2(v0[2], v0[3]); w.z = pk2(v1[0], v1[1]); w.w = pk2(v1[2], v1[3]);
                    *(u32x4*)(rowp + bj * 128) = w; } }
    }
};
struct EpiOut {
    static constexpr bool PERM = false, AFTER_DRAIN = false;
    const float* xin; float* xout; bf16_t* xb; float* rsq;
    DI void operator()(const f32x4 (&acc)[2][2][4][2], const pg8::Unit& u, int wr, int wc, int fr, int fq) const {
        const int row0 = u.pm * 256 + wr * 64 + fr, col0 = u.pn * 256 + wc * 32 + 4 * fq;
#pragma unroll
        for (int ai = 0; ai < 2; ++ai)
#pragma unroll
            for (int m = 0; m < 4; ++m) {
                const int row = row0 + ai * 128 + m * 16; float ss = 0.f;
#pragma unroll
                for (int bj = 0; bj < 2; ++bj)
#pragma unroll
                    for (int n = 0; n < 2; ++n) {
                        const size_t o = (size_t)row * 2048 + col0 + bj * 128 + n * 16;
                        const f32x4 v = *(const f32x4*)(xin + o) + acc[ai][bj][m][n];
                        *(f32x4*)(xout + o) = v;
                        if (rsq) { st4bf(xb + o, v); ss += v[0] * v[0] + v[1] * v[1] + v[2] * v[2] + v[3] * v[3]; } }
                if (rsq) { ss += __shfl_xor(ss, 16); ss += __shfl_xor(ss, 32); if (fq == 0) rsq[(size_t)row * 32 + u.pn * 4 + wc] = ss; } }
    }
};

DI void tr_weight(float* tile, const float* src, int K, int N, const float* g, bf16_t* dst, int k0, int n0) {
    const int tid = tidl();
#pragma unroll
    for (int i = 0; i < 8; ++i) { const int r = (tid >> 6) + 8 * i, nn = tid & 63, k = k0 + r, n = n0 + nn;
        tile[r * 65 + nn] = (n < N) ? src[(size_t)k * N + n] * (g ? g[k] : 1.f) : 0.f; }
    __syncthreads();
    { const int n = tid >> 3, kg = (tid & 7) * 8; u32x4 w;
      w.x = pk2(tile[(kg + 0) * 65 + n], tile[(kg + 1) * 65 + n]); w.y = pk2(tile[(kg + 2) * 65 + n], tile[(kg + 3) * 65 + n]);
      w.z = pk2(tile[(kg + 4) * 65 + n], tile[(kg + 5) * 65 + n]); w.w = pk2(tile[(kg + 6) * 65 + n], tile[(kg + 7) * 65 + n]);
      *(u32x4*)(dst + (size_t)(n0 + n) * K + k0 + kg) = w; }
    __syncthreads();
}
DI void phase0(const Params& P, unsigned char* sm) {
    float* tile = (float*)sm;
    const int tid = tidl(), wid = tid >> 6, lane = tid & 63, G = gridDim.x, bid = blockIdx.x;
    constexpr int T_IN = 32 * 100, T_OUT = 32 * 32, T_UQ = 6 * 12, T_UKV = 2 * 16, T_ALL = NLAYER * (T_IN + T_OUT + T_UQ + T_UKV);
    for (int it = bid; it < T_ALL; it += G) {
        int l = it / (T_IN + T_OUT + T_UQ + T_UKV), r = it % (T_IN + T_OUT + T_UQ + T_UKV);
        if (r < T_IN) { const int kt = r / 100, nt = r % 100;
            tr_weight(tile, P.w_in + (size_t)l * 2048 * NIN, 2048, NIN, P.ln_g + l * 2048, P.WinT() + (size_t)l * NINP * 2048, kt * 64, nt * 64); }
        else if ((r -= T_IN) < T_OUT) { const int kt = r / 32, nt = r % 32;
            tr_weight(tile, P.w_out + (size_t)l * 2048 * 2048, 2048, 2048, nullptr, P.WoutT() + (size_t)l * 2048 * 2048, kt * 64, nt * 64); }
        else if ((r -= T_OUT) < T_UQ) { const int kt = r / 12, nt = r % 12;
            tr_weight(tile, P.wuq + (size_t)l * 384 * 768, 384, 768, P.qng + l * 384, P.WuqT() + (size_t)l * 768 * 384, kt * 64, nt * 64); }
        else { r -= T_UQ; const int kt = r / 16, nt = r % 16;
            tr_weight(tile, P.wukv + (size_t)l * 128 * 1024, 128, 1024, P.kvng + l * 128, P.WukvT() + (size_t)l * 1024 * 128, kt * 64, nt * 64); }
    }
    for (int row = bid * 8 + wid; row < T_; row += G * 8) {
        const float* xr = P.x + (size_t)row * 2048; float ss = 0.f;
#pragma unroll
        for (int i = 0; i < 8; ++i) { const int c = lane * 4 + 256 * i; const f32x4 v = *(const f32x4*)(xr + c);
            ss += v[0] * v[0] + v[1] * v[1] + v[2] * v[2] + v[3] * v[3]; st4bf(P.xb() + (size_t)row * 2048 + c, v); }
        ss = wsum(ss); if (lane < 32) P.rowsq()[(size_t)row * 32 + lane] = (lane == 0) ? ss : 0.f;
    }
    const int gtid = bid * 512 + tid, gn = G * 512;
    if (gtid < 16) P.ctr()[gtid] = 0u;
    for (int e = gtid; e < T_ * 96; e += gn) {
        const int tok = e / 96, j = e % 96; const double pos = (double)P.pos[tok];
        const bool isM = j < 32; const int jj = isM ? j : j - 32; const double dd = isM ? 64.0 : 128.0;
        const double invf = exp(-9.210340371976184 * (double)jj * (2.0 / dd));
        double ang = pos * invf; const double kq = rint(ang * 0.15915494309189535); ang = ang - kq * 6.283185307179586;
        const float a = (float)ang; const float c = cosf(a), s = sinf(a);
        if (isM) { P.cosM()[tok * 32 + jj] = c; P.sinM()[tok * 32 + jj] = s; } else { P.cosD()[tok * 64 + jj] = c; P.sinD()[tok * 64 + jj] = s; }
    }
}

DI void tr_out(const bf16_t* tile, int ld, int Wlog, bf16_t* dst, int t0, int d) {
    const int run = 64 / d, W = 1 << Wlog;
    for (int unit = tidl(); unit < W * 16; unit += 512) {
        const int c = unit & (W - 1), g = unit >> Wlog, pi = 4 * g, r = pi / run, off = pi % run;
        const unsigned a0 = tile[((off + 0) * d + r) * ld + c], a1 = tile[((off + 1) * d + r) * ld + c], a2 = tile[((off + 2) * d + r) * ld + c], a3 = tile[((off + 3) * d + r) * ld + c];
        u32x2 w; w.x = a0 | (a1 << 16); w.y = a2 | (a3 << 16);
        *(u32x2*)(dst + (size_t)c * S_ + r * (S_ / d) + t0 / d + off) = w; }
}

DI void p2_gla(const Params& P, int l, int b, int t0, unsigned char* sm) {
    bf16_t* QeL = (bf16_t*)sm; bf16_t* KeL = (bf16_t*)(sm + 33792); bf16_t* vL = (bf16_t*)sm; bf16_t* KdL = (bf16_t*)(sm + 67584);
    float* attnL = (float*)(sm + 101376); float* alrL = (float*)(sm + 117760);
    const int tid = tidl(); const size_t tokb = (size_t)b * S_ + t0;
    for (int e = tid; e < 1024; e += 512) alrL[e] = bf2f(P.u()[(tokb + (e >> 4)) * NINP + U_ALR + (e & 15)]);
    __syncthreads();
    {
        const int c = tid & 255, half = tid >> 8;
        float w2r[16];
#pragma unroll
        for (int r = 0; r < 16; ++r) w2r[r] = P.gw2[(l * 16 + r) * 256 + c];
        const float bias = P.gb[l * 256 + c];
#pragma unroll
        for (int chh = 0; chh < 2; ++chh) {
            const int ch = half * 2 + chh; float bc[16]; float run = 0.f;
#pragma unroll
            for (int i = 0; i < 16; ++i) { const int tl = ch * 16 + i; float pre = bias;
#pragma unroll
                for (int r = 0; r < 16; ++r) pre += alrL[tl * 16 + r] * w2r[r];
                const float ls = fminf(pre, 0.f) - log1pf(__expf(-fabsf(pre))); run += ls * (1.0f / 16.0f); bc[i] = run; }
            const float bl = run;
#pragma unroll
            for (int i = 0; i < 16; ++i) { const int tl = ch * 16 + i; const size_t tok = tokb + tl;
                const float q = bf2f(P.u()[tok * NINP + U_AQ + c]), k = bf2f(P.u()[tok * NINP + U_AK + c]);
                const bf16_t qeb = f2bf(q * 0.125f * __expf(bc[i]));
                P.Qe()[tok * 256 + c] = qeb; QeL[tl * 264 + c] = qeb; KeL[tl * 264 + c] = f2bf(k * __expf(-bc[i])); KdL[tl * 264 + c] = f2bf(k * __expf(bl - bc[i])); }
            P.dec()[((size_t)b * 256 + (t0 >> 4) + ch) * 256 + c] = __expf(bl);
        }
    }
    __syncthreads();
#pragma unroll 2
    for (int rr = 0; rr < 8; ++rr) { const int e = tid + 512 * rr, combo = e >> 8, i = (e >> 4) & 15, j = e & 15, ch = combo >> 2, h = combo & 3;
        float a = 0.f;
        if (j <= i) { const bf16_t* qp = QeL + (ch * 16 + i) * 264 + h * 64; const bf16_t* kp = KeL + (ch * 16 + j) * 264 + h * 64;
#pragma unroll
            for (int d8 = 0; d8 < 8; ++d8) { const u32x4 qv = *(const u32x4*)(qp + d8 * 8), kv = *(const u32x4*)(kp + d8 * 8);
                a += lo2f(qv.x) * lo2f(kv.x) + hi2f(qv.x) * hi2f(kv.x) + lo2f(qv.y) * lo2f(kv.y) + hi2f(qv.y) * hi2f(kv.y)
                   + lo2f(qv.z) * lo2f(kv.z) + hi2f(qv.z) * hi2f(kv.z) + lo2f(qv.w) * lo2f(kv.w) + hi2f(qv.w) * hi2f(kv.w); } }
        attnL[e] = a; }
    tr_out(KdL, 264, 8, P.KdT() + (size_t)b * 256 * S_, t0, 1);
    __syncthreads();
    for (int e = tid; e < 4096; e += 512) { const int tl = e >> 6, c8 = (e & 63) * 8; *(u32x4*)(vL + tl * 520 + c8) = *(const u32x4*)(P.u() + (tokb + tl) * NINP + U_AV + c8); }
    __syncthreads();
    { const int cc = tid, h = cc >> 7;
      for (int ch = 0; ch < 4; ++ch) { float vv[16];
#pragma unroll
          for (int j = 0; j < 16; ++j) vv[j] = bf2f(vL[(ch * 16 + j) * 520 + cc]);
          const float* ap = attnL + (ch * 4 + h) * 256;
#pragma unroll
          for (int i = 0; i < 16; ++i) { float o = 0.f;
#pragma unroll
              for (int j4 = 0; j4 < 4; ++j4) { const f32x4 av = *(const f32x4*)(ap + i * 16 + j4 * 4); o += av[0] * vv[j4 * 4] + av[1] * vv[j4 * 4 + 1] + av[2] * vv[j4 * 4 + 2] + av[3] * vv[j4 * 4 + 3]; }
              P.ogla()[(tokb + ch * 16 + i) * 512 + cc] = o; } } }
    tr_out(vL, 520, 9, P.gvT() + (size_t)b * 512 * S_, t0, 1);
    __syncthreads();
}

DI void p2_ssd(const Params& P, int l, int b, int t0, unsigned char* sm) {
    bf16_t* xdtL = (bf16_t*)sm; bf16_t* bmL = (bf16_t*)(sm + 66560); float* dtL = (float*)(sm + 100352); float* facL = (float*)(sm + 104448);
    const int tid = tidl(), wid = tid >> 6, lane = tid & 63; const size_t tokb = (size_t)b * S_ + t0; const int cidx = t0 >> 6;
    { const int h = wid; const float raw = bf2f(P.u()[(tokb + lane) * NINP + U_DT + h]) + P.dtb[l * 8 + h];
      const float dtv = fmaxf(raw, 0.f) + log1pf(__expf(-fabsf(raw)));
      const float a = -dtv * __expf(P.alog[l * 8 + h]);
      float cs = a;
#pragma unroll
      for (int o = 1; o < 64; o <<= 1) { const float t = __shfl_up(cs, o); if (lane >= o) cs += t; }
      const float last = __shfl(cs, 63);
      dtL[h * 64 + lane] = dtv; facL[h * 64 + lane] = __expf(last - cs);
      P.Acs()[(((size_t)b * 64 + cidx) * 8 + h) * 64 + lane] = cs; }
    __syncthreads();
    { const int ch0 = 2 * tid; float w0[4], w1[4];
#pragma unroll
      for (int j = 0; j < 4; ++j) { w0[j] = P.cw[(l * 4 + j) * 1024 + ch0]; w1[j] = P.cw[(l * 4 + j) * 1024 + ch0 + 1]; }
      const float cb0 = P.cb[l * 1024 + ch0], cb1 = P.cb[l * 1024 + ch0 + 1];
      float a0 = 0.f, a1 = 0.f, a2 = 0.f, b0 = 0.f, b1 = 0.f, b2 = 0.f;
      if (t0 > 0) { const unsigned v0 = *(const unsigned*)(P.u() + (tokb - 3) * NINP + U_XBC + ch0), v1 = *(const unsigned*)(P.u() + (tokb - 2) * NINP + U_XBC + ch0), v2 = *(const unsigned*)(P.u() + (tokb - 1) * NINP + U_XBC + ch0);
          a0 = lo2f(v0); b0 = hi2f(v0); a1 = lo2f(v1); b1 = hi2f(v1); a2 = lo2f(v2); b2 = hi2f(v2); }
      const int role = ch0 < 512 ? 0 : (ch0 < 768 ? 1 : 2), hh = (ch0 >> 6) & 7;
#pragma unroll 16
      for (int tl = 0; tl < 64; ++tl) { const unsigned v = *(const unsigned*)(P.u() + (tokb + tl) * NINP + U_XBC + ch0); const float x0 = lo2f(v), x1 = hi2f(v);
          const float c0 = cb0 + a0 * w0[0] + a1 * w0[1] + a2 * w0[2] + x0 * w0[3], c1 = cb1 + b0 * w1[0] + b1 * w1[1] + b2 * w1[2] + x1 * w1[3];
          a0 = a1; a1 = a2; a2 = x0; b0 = b1; b1 = b2; b2 = x1;
          const float s0 = silu_f(c0), s1 = silu_f(c1);
          if (role == 0) { const float dtv = dtL[hh * 64 + tl];
              *(unsigned*)(P.xs() + (tokb + tl) * 512 + ch0) = pk2(s0, s1); *(unsigned*)(xdtL + tl * 520 + ch0) = pk2(s0 * dtv, s1 * dtv); }
          else if (role == 1) { const unsigned w = pk2(s0, s1); *(unsigned*)(P.Bm() + (tokb + tl) * 256 + (ch0 - 512)) = w; *(unsigned*)(bmL + tl * 264 + (ch0 - 512)) = w; }
          else { *(unsigned*)(P.Cm() + (tokb + tl) * 256 + (ch0 - 768)) = pk2(s0, s1); } } }
    __syncthreads();
    for (int unit = tid; unit < 8192; unit += 512) { const int c = unit & 511, g = unit >> 9, h = c >> 6, tl0 = 4 * g;
        f32x4 v; v[0] = bf2f(xdtL[(tl0 + 0) * 520 + c]); v[1] = bf2f(xdtL[(tl0 + 1) * 520 + c]); v[2] = bf2f(xdtL[(tl0 + 2) * 520 + c]); v[3] = bf2f(xdtL[(tl0 + 3) * 520 + c]);
        const size_t o = ((size_t)b * 512 + c) * S_ + t0 + tl0;
        st4bf(P.XdtT() + o, v);
        const f32x4 f = *(const f32x4*)(facL + h * 64 + tl0);
        st4bf(P.XdT() + o, v * f); }
    tr_out(bmL, 264, 8, P.BmT() + (size_t)b * 256 * S_, t0, 1);
    __syncthreads();
}

DI void head_norm_rope_store(f32x4 (&x)[12], const float* hg, const float* cosp, const float* sinp, float scale, bf16_t* dstrow, int fq) {
    float ss = 0.f;
#pragma unroll
    for (int nt = 0; nt < 12; ++nt) ss += x[nt][0] * x[nt][0] + x[nt][1] * x[nt][1] + x[nt][2] * x[nt][2] + x[nt][3] * x[nt][3];
    ss += __shfl_xor(ss, 16); ss += __shfl_xor(ss, 32);
    const float rs = rsqrtf(ss * (1.0f / 192.0f) + EPS_);
#pragma unroll
    for (int nt = 0; nt < 12; ++nt) { const f32x4 g = *(const f32x4*)(hg + nt * 16 + fq * 4); x[nt] = x[nt] * rs * g; }
#pragma unroll
    for (int nt = 8; nt < 10; ++nt) { const f32x4 c = *(const f32x4*)(cosp + (nt - 8) * 16 + fq * 4), s = *(const f32x4*)(sinp + (nt - 8) * 16 + fq * 4);
        const f32x4 x1 = x[nt], x2 = x[nt + 2]; x[nt] = x1 * c - x2 * s; x[nt + 2] = x2 * c + x1 * s; }
#pragma unroll
    for (int nt = 0; nt < 12; ++nt) st4bf(dstrow + nt * 16 + fq * 4, x[nt] * scale);
}

DI void p2_mla(const Params& P, int l, int b, int t0, unsigned char* sm) {
    bf16_t* cqL = (bf16_t*)sm; bf16_t* ckvL = (bf16_t*)(sm + 50176);
    const int tid = tidl(), wid = tid >> 6, lane = tid & 63, fr = lane & 15, fq = lane >> 4; const size_t tokb = (size_t)b * S_ + t0;
#pragma unroll 2
    for (int i = 0; i < 8; ++i) { const int tl = wid * 8 + i; const bf16_t* up = P.u() + (tokb + tl) * NINP;
        float xq[6], ss = 0.f;
#pragma unroll
        for (int k = 0; k < 6; ++k) { xq[k] = bf2f(up[U_CQ + lane + 64 * k]); ss += xq[k] * xq[k]; }
        ss = wsum(ss); const float rs = rsqrtf(ss * (1.0f / 384.0f) + EPS_);
#pragma unroll
        for (int k = 0; k < 6; ++k) cqL[tl * 392 + lane + 64 * k] = f2bf(xq[k] * rs);
        const float k0 = bf2f(up[U_CKV + lane]), k1 = bf2f(up[U_CKV + lane + 64]);
        const float s2 = wsum(k0 * k0 + k1 * k1), rs2 = rsqrtf(s2 * (1.0f / 128.0f) + EPS_);
        ckvL[tl * 136 + lane] = f2bf(k0 * rs2); ckvL[tl * 136 + lane + 64] = f2bf(k1 * rs2); }
    __syncthreads();
    const int h = wid >> 1, tp = wid & 1;
    const bf16_t* Wq = P.WuqT() + (size_t)l * 768 * 384 + (size_t)(h * 192) * 384;
    const bf16_t* Wkv = P.WukvT() + (size_t)l * 1024 * 128 + (size_t)(h * 256) * 128;
#pragma unroll 1
    for (int tt = 0; tt < 2; ++tt) {
        const int tl = (2 * tp + tt) * 16 + fr; const size_t tok = tokb + tl;
        {
            f32x4 x[12];
#pragma unroll
            for (int nt = 0; nt < 12; ++nt) x[nt] = fz4();
#pragma unroll 1
            for (int ks = 0; ks < 12; ++ks) {
                const bf16x8 b0 = *(const bf16x8*)(cqL + tl * 392 + ks * 32 + fq * 8);
#pragma unroll
                for (int nt = 0; nt < 12; ++nt) x[nt] = mfma16(*(const bf16x8*)(Wq + (size_t)(nt * 16 + fr) * 384 + ks * 32 + fq * 8), b0, x[nt]); }
            head_norm_rope_store(x, P.qhg + l * 192, P.cosM() + tok * 32, P.sinM() + tok * 32, 0.07216878364870322f * LOG2E, P.Qc() + (tok * 4 + h) * 192, fq);
        }
        {
            f32x4 x[12];
#pragma unroll
            for (int nt = 0; nt < 8; ++nt) x[nt] = fz4();
#pragma unroll 1
            for (int ks = 0; ks < 4; ++ks) {
                const bf16x8 b0 = *(const bf16x8*)(ckvL + tl * 136 + ks * 32 + fq * 8);
#pragma unroll
                for (int nt = 0; nt < 8; ++nt) x[nt] = mfma16(*(const bf16x8*)(Wkv + (size_t)(nt * 16 + fr) * 128 + ks * 32 + fq * 8), b0, x[nt]); }
#pragma unroll
            for (int nt = 8; nt < 12; ++nt) x[nt] = ld4bf(P.u() + tok * NINP + U_CKR + (nt - 8) * 16 + fq * 4);
            head_norm_rope_store(x, P.khg + l * 192, P.cosM() + tok * 32, P.sinM() + tok * 32, 1.0f, P.Kc() + (((size_t)(b * 4 + h)) * S_ + t0 + tl) * 192, fq);
        }
        {
            f32x4 x[8];
#pragma unroll
            for (int nt = 0; nt < 8; ++nt) x[nt] = fz4();
#pragma unroll 1
            for (int ks = 0; ks < 4; ++ks) {
                const bf16x8 b0 = *(const bf16x8*)(ckvL + tl * 136 + ks * 32 + fq * 8);
#pragma unroll
                for (int nt = 0; nt < 8; ++nt) x[nt] = mfma16(*(const bf16x8*)(Wkv + (size_t)(128 + nt * 16 + fr) * 128 + ks * 32 + fq * 8), b0, x[nt]); }
#pragma unroll
            for (int nt = 0; nt < 8; ++nt)
#pragma unroll
                for (int i = 0; i < 4; ++i) P.Vct()[((size_t)b * 512 + h * 128 + nt * 16 + fq * 4 + i) * S_ + t0 + tl] = f2bf(x[nt][i]);
        }
    }
    __syncthreads();
}

DI void p2_dil(const Params& P, int l, int b, int t0, unsigned char* sm) {
    bf16_t* vL = (bf16_t*)sm;
    const int tid = tidl(), wid = tid >> 6, lane = tid & 63; const size_t tokb = (size_t)b * S_ + t0;
    const float gq1 = P.dqg[l * 128 + lane], gq2 = P.dqg[l * 128 + 64 + lane], gk1 = P.dkg[l * 128 + lane], gk2 = P.dkg[l * 128 + 64 + lane];
#pragma unroll 4
    for (int rr = 0; rr < 64; ++rr) { const int row = wid * 64 + rr, qk = row & 1, h = (row >> 1) & 3, tl = row >> 3; const size_t tok = tokb + tl;
        const bf16_t* up = P.u() + tok * NINP + (qk ? U_DK : U_DQ) + h * 128; const float x1 = bf2f(up[lane]), x2 = bf2f(up[lane + 64]);
        const float ss = wsum(x1 * x1 + x2 * x2), rs = rsqrtf(ss * (1.0f / 128.0f) + EPS_);
        const float y1 = x1 * rs * (qk ? gk1 : gq1), y2 = x2 * rs * (qk ? gk2 : gq2);
        const float c = P.cosD()[tok * 64 + lane], s = P.sinD()[tok * 64 + lane]; const float sc = qk ? 1.0f : 0.08838834764831845f * LOG2E;
        bf16_t* dp = (qk ? P.dk() : P.dq()) + tok * 512 + h * 128; dp[lane] = f2bf((y1 * c - y2 * s) * sc); dp[lane + 64] = f2bf((y2 * c + y1 * s) * sc); }
    for (int e = tid; e < 4096; e += 512) { const int tl = e >> 6, c8 = (e & 63) * 8; *(u32x4*)(vL + tl * 520 + c8) = *(const u32x4*)(P.u() + (tokb + tl) * NINP + U_DV + c8); }
    __syncthreads();
    tr_out(vL, 520, 9, P.Vt1() + (size_t)b * 512 * S_, t0, 1);
    tr_out(vL, 520, 9, P.Vt4() + (size_t)b * 512 * S_, t0, 4);
    tr_out(vL, 520, 9, P.Vt16() + (size_t)b * 512 * S_, t0, 16);
    __syncthreads();
}

DI void phase2(const Params& P, int l, unsigned char* sm) {
    for (int it = blockIdx.x; it < 256; it += gridDim.x) { const int b = it >> 6, t0 = (it & 63) * 64;
#ifndef ONLY_P2
#define ONLY_P2 -1
#endif
        if (ONLY_P2 < 0 || ONLY_P2 == 1) p2_gla(P, l, b, t0, sm); if (ONLY_P2 < 0 || ONLY_P2 == 2) p2_ssd(P, l, b, t0, sm);
        if (ONLY_P2 < 0 || ONLY_P2 == 3) p2_mla(P, l, b, t0, sm); if (ONLY_P2 < 0 || ONLY_P2 == 4) p2_dil(P, l, b, t0, sm); }
}

DI void p3_gla(const Params& P, int b, int h, int w) {
    const int lane = tidl() & 63, fr = lane & 15, fq = lane >> 4, dv0 = w * 16;
    f32x4 Sa[4] = {fz4(), fz4(), fz4(), fz4()};
    const bf16_t* Qe = P.Qe() + (size_t)b * S_ * 256 + h * 64;
    const bf16_t* KdT = P.KdT() + ((size_t)b * 256 + h * 64) * S_;
    const bf16_t* vT = P.gvT() + ((size_t)b * 512 + h * 128 + dv0 + fr) * S_;
    const float* dec = P.dec() + (size_t)b * 256 * 256 + h * 64;
    float* og = P.ogla() + (size_t)b * S_ * 512 + h * 128 + dv0 + fr;
    bf16x8 qa[2], ka[4], vb; f32x4 dc[4], oi;
    bf16x8 nqa[2], nka[4], nvb; f32x4 ndc[4], noi;
#define GLA_LOAD(n, QA, KA, VB, DC, OI) do { const int tok0_ = 16 * (n); \
        _Pragma("unroll") for (int s = 0; s < 2; ++s) QA[s] = ldperm(Qe + (size_t)(tok0_ + fr) * 256 + 32 * s, fq); \
        _Pragma("unroll") for (int kt = 0; kt < 4; ++kt) { KA[kt] = zero8(); if (fq < 2) KA[kt] = *(const bf16x8*)(KdT + (size_t)(16 * kt + fr) * S_ + tok0_ + 8 * fq); } \
        VB = zero8(); if (fq < 2) VB = *(const bf16x8*)(vT + tok0_ + 8 * fq); \
        _Pragma("unroll") for (int kt = 0; kt < 4; ++kt) DC[kt] = *(const f32x4*)(dec + (size_t)(n) * 256 + 16 * kt + 4 * fq); \
        _Pragma("unroll") for (int i = 0; i < 4; ++i) OI[i] = og[(size_t)(tok0_ + 4 * fq + i) * 512]; } while (0)
    GLA_LOAD(0, qa, ka, vb, dc, oi);
#pragma unroll 1
    for (int n = 0; n < 256; ++n) {
        const int nn = (n + 1 < 256) ? n + 1 : n;
        GLA_LOAD(nn, nqa, nka, nvb, ndc, noi);
        f32x4 o = fz4();
#pragma unroll
        for (int s = 0; s < 2; ++s) o = mfma16(qa[s], pack8(Sa[2 * s], Sa[2 * s + 1]), o);
#pragma unroll
        for (int i = 0; i < 4; ++i) og[(size_t)(16 * n + 4 * fq + i) * 512] = o[i] + oi[i];
#pragma unroll
        for (int kt = 0; kt < 4; ++kt) { Sa[kt] = Sa[kt] * dc[kt]; Sa[kt] = mfma16(ka[kt], vb, Sa[kt]); }
#pragma unroll
        for (int s = 0; s < 2; ++s) qa[s] = nqa[s];
#pragma unroll
        for (int kt = 0; kt < 4; ++kt) { ka[kt] = nka[kt]; dc[kt] = ndc[kt]; }
        vb = nvb; oi = noi;
    }
#undef GLA_LOAD
}

DI void p3_ssd(const Params& P, int l, int b, int h, int ps) {
    const int lane = tidl() & 63, fr = lane & 15, fq = lane >> 4, g = h >> 2, p0 = ps * 16;
    f32x4 st[8];
#pragma unroll
    for (int i = 0; i < 8; ++i) st[i] = fz4();
    const float Dh = P.sD[l * 8 + h];
    const bf16_t* Bm = P.Bm() + (size_t)b * S_ * 256 + g * 128; const bf16_t* Cm = P.Cm() + (size_t)b * S_ * 256 + g * 128;
    const bf16_t* BmT = P.BmT() + ((size_t)b * 256 + g * 128) * S_;
    const bf16_t* XdT = P.XdT() + ((size_t)b * 512 + h * 64 + p0 + fr) * S_; const bf16_t* XdtT = P.XdtT() + ((size_t)b * 512 + h * 64 + p0 + fr) * S_;
    const bf16_t* xs = P.xs() + (size_t)b * S_ * 512 + h * 64 + p0; float* ys = P.yssd() + (size_t)b * S_ * 512 + h * 64 + p0;
#pragma unroll 1
    for (int c = 0; c < 64; ++c) {
        const int tok0 = 64 * c; const float* acs = P.Acs() + (((size_t)b * 64 + c) * 8 + h) * 64;
        float acl[4]; f32x4 acsS[4];
#pragma unroll
        for (int t = 0; t < 4; ++t) { acl[t] = acs[16 * t + fr]; acsS[t] = *(const f32x4*)(acs + 16 * t + 4 * fq); }
        const float elast = __expf(acs[63]);
        bf16x8 Cp[4][4];
#pragma unroll
        for (int lt = 0; lt < 4; ++lt)
#pragma unroll
            for (int ks = 0; ks < 4; ++ks) Cp[lt][ks] = ldperm(Cm + (size_t)(tok0 + 16 * lt + fr) * 256 + 32 * ks, fq);
        f32x4 yacc[4];
#pragma unroll
        for (int lt = 0; lt < 4; ++lt) { f32x4 yo = fz4();
#pragma unroll
            for (int ks = 0; ks < 4; ++ks) yo = mfma16(pack8(st[2 * ks], st[2 * ks + 1]), Cp[lt][ks], yo);
            const f32x4 xv = ld4bf(xs + (size_t)(tok0 + 16 * lt + fr) * 512 + 4 * fq);
            yacc[lt] = yo * __expf(acl[lt]) + xv * Dh; }
#pragma unroll
        for (int ks2 = 0; ks2 < 2; ++ks2) {
            bf16x8 Bp0[4], Bp1[4];
#pragma unroll
            for (int ks = 0; ks < 4; ++ks) { Bp0[ks] = ldperm(Bm + (size_t)(tok0 + 32 * ks2 + fr) * 256 + 32 * ks, fq); Bp1[ks] = ldperm(Bm + (size_t)(tok0 + 32 * ks2 + 16 + fr) * 256 + 32 * ks, fq); }
            const bf16x8 xa = ldperm(XdtT + tok0 + 32 * ks2, fq);
#pragma unroll
            for (int lt = 2 * ks2; lt < 4; ++lt) {
                f32x4 g0 = fz4(), g1 = fz4();
#pragma unroll
                for (int ks = 0; ks < 4; ++ks) { g0 = mfma16(Bp0[ks], Cp[lt][ks], g0); g1 = mfma16(Bp1[ks], Cp[lt][ks], g1); }
                const int lpos = 16 * lt + fr;
#pragma unroll
                for (int i = 0; i < 4; ++i) { const int s0 = 32 * ks2 + 4 * fq + i, s1 = s0 + 16;
                    const float e0 = __expf(acl[lt] - acsS[2 * ks2][i]), e1 = __expf(acl[lt] - acsS[2 * ks2 + 1][i]);
                    g0[i] = (s0 <= lpos) ? g0[i] * e0 : 0.f; g1[i] = (s1 <= lpos) ? g1[i] * e1 : 0.f; }
                yacc[lt] = mfma16(xa, pack8(g0, g1), yacc[lt]);
            }
        }
#pragma unroll
        for (int lt = 0; lt < 4; ++lt) *(f32x4*)(ys + (size_t)(tok0 + 16 * lt + fr) * 512 + 4 * fq) = yacc[lt];
        const bf16x8 xd0 = *(const bf16x8*)(XdT + tok0 + 8 * fq), xd1 = *(const bf16x8*)(XdT + tok0 + 32 + 8 * fq);
#pragma unroll
        for (int nt = 0; nt < 8; ++nt) { st[nt] = st[nt] * elast;
            st[nt] = mfma16(*(const bf16x8*)(BmT + (size_t)(16 * nt + fr) * S_ + tok0 + 8 * fq), xd0, st[nt]);
            st[nt] = mfma16(*(const bf16x8*)(BmT + (size_t)(16 * nt + fr) * S_ + tok0 + 32 + 8 * fq), xd1, st[nt]); }
    }
}

DI void p3_mla(const Params& P, int b, int h, int qb, unsigned char* sm) {
    bf16_t* KL = (bf16_t*)sm; bf16_t* VL = (bf16_t*)(sm + 25600);
    const int tid = tidl(), wid = tid >> 6, lane = tid & 63, fr = lane & 15, fq = lane >> 4;
    const int qrow = qb * 128 + wid * 16 + fr; const size_t tokq = (size_t)b * S_ + qrow;
    bf16x8 Qf[6];
#pragma unroll
    for (int ks = 0; ks < 6; ++ks) Qf[ks] = *(const bf16x8*)(P.Qc() + (tokq * 4 + h) * 192 + ks * 32 + fq * 8);
    f32x4 oacc[8];
#pragma unroll
    for (int i = 0; i < 8; ++i) oacc[i] = fz4();
    float m = -1e30f, lsum = 0.f;
    const bf16_t* Kg = P.Kc() + ((size_t)(b * 4 + h)) * S_ * 192; const bf16_t* Vg = P.Vct() + ((size_t)b * 512 + h * 128) * S_;
    const int nkt = 2 * qb + 2;
    u32x4 kr[3], vr[2];
#define MLA_GLOAD(kt) do { _Pragma("unroll") for (int i = 0; i < 3; ++i) { const int e = tid + 512 * i, row = e / 24, c16 = e % 24; kr[i] = *(const u32x4*)(Kg + (size_t)((kt) * 64 + row) * 192 + c16 * 8); } \
                           _Pragma("unroll") for (int i = 0; i < 2; ++i) { const int e = tid + 512 * i, row = e >> 3, c16 = e & 7; vr[i] = *(const u32x4*)(Vg + (size_t)row * S_ + (kt) * 64 + c16 * 8); } } while (0)
    MLA_GLOAD(0);
#pragma unroll 1
    for (int kt = 0; kt < nkt; ++kt) {
        __syncthreads();
#pragma unroll
        for (int i = 0; i < 3; ++i) { const int e = tid + 512 * i, row = e / 24, c16 = e % 24; *(u32x4*)(KL + row * 200 + c16 * 8) = kr[i]; }
#pragma unroll
        for (int i = 0; i < 2; ++i) { const int e = tid + 512 * i, row = e >> 3, c16 = e & 7; *(u32x4*)(VL + row * 72 + c16 * 8) = vr[i]; }
        __syncthreads();
        if (kt + 1 < nkt) MLA_GLOAD(kt + 1);
        if (kt * 64 <= qb * 128 + wid * 16 + 15) {
            f32x4 s[4];
#pragma unroll
            for (int j = 0; j < 4; ++j) { s[j] = fz4();
#pragma unroll
                for (int ks = 0; ks < 6; ++ks) s[j] = mfma16(*(const bf16x8*)(KL + (j * 16 + fr) * 200 + ks * 32 + fq * 8), Qf[ks], s[j]); }
            if (kt >= 2 * qb) {
#pragma unroll
                for (int j = 0; j < 4; ++j)
#pragma unroll
                    for (int i = 0; i < 4; ++i) { const int key = kt * 64 + j * 16 + fq * 4 + i; if (key > qrow) s[j][i] = -1e30f; } }
            float mx = -1e30f;
#pragma unroll
            for (int j = 0; j < 4; ++j) mx = fmaxf(mx, fmaxf(fmaxf(s[j][0], s[j][1]), fmaxf(s[j][2], s[j][3])));
            mx = fmaxf(mx, __shfl_xor(mx, 16)); mx = fmaxf(mx, __shfl_xor(mx, 32));
            const float mn = fmaxf(m, mx), alpha = __builtin_amdgcn_exp2f(m - mn); m = mn;
            float psum = 0.f;
#pragma unroll
            for (int j = 0; j < 4; ++j)
#pragma unroll
                for (int i = 0; i < 4; ++i) { s[j][i] = __builtin_amdgcn_exp2f(s[j][i] - mn); psum += s[j][i]; }
            lsum = lsum * alpha + psum;
#pragma unroll
            for (int dt = 0; dt < 8; ++dt) oacc[dt] = oacc[dt] * alpha;
#pragma unroll
            for (int kk = 0; kk < 2; ++kk) { const bf16x8 pb = pack8(s[2 * kk], s[2 * kk + 1]);
#pragma unroll
                for (int dt = 0; dt < 8; ++dt) oacc[dt] = mfma16(ldperm(VL + (dt * 16 + fr) * 72 + kk * 32, fq), pb, oacc[dt]); }
        }
    }
#undef MLA_GLOAD
    lsum += __shfl_xor(lsum, 16); lsum += __shfl_xor(lsum, 32); const float inv = 1.0f / lsum;
#pragma unroll
    for (int dt = 0; dt < 8; ++dt) { const f32x4 gv = ld4bf(P.u() + tokq * NINP + U_GC + h * 128 + dt * 16 + fq * 4); f32x4 o = oacc[dt] * inv;
        o[0] *= silu_f(gv[0]); o[1] *= silu_f(gv[1]); o[2] *= silu_f(gv[2]); o[3] *= silu_f(gv[3]);
        st4bf(P.y() + tokq * 2048 + 1024 + h * 128 + dt * 16 + fq * 4, o); }
}

DI void dil_cfg(const bf16_t* dkb, const bf16_t* vtb, int d, int Pn, int rd, int p0, int pstep, int nks, const bf16x8 (&Qf)[4], f32x4 (&oacc)[8], float& lsum, float Mb, int fr, int fq) {
    const int kbase = (p0 - 128) & ~7, pq = p0 + fr * pstep;
#pragma unroll 1
    for (int kk = 0; kk < nks; ++kk) { const int k0 = kbase + 32 * kk;
        f32x4 s0 = fz4(), s1 = fz4();
        { const int kp = k0 + fr; const bool ok = (kp >= 0) && (kp < Pn); const bf16_t* rp = dkb + (size_t)(ok ? kp * d + rd : 0) * 512;
#pragma unroll
          for (int ks = 0; ks < 4; ++ks) { bf16x8 a = *(const bf16x8*)(rp + 32 * ks + 8 * fq); if (!ok) a = zero8(); s0 = mfma16(a, Qf[ks], s0); } }
        { const int kp = k0 + 16 + fr; const bool ok = (kp >= 0) && (kp < Pn); const bf16_t* rp = dkb + (size_t)(ok ? kp * d + rd : 0) * 512;
#pragma unroll
          for (int ks = 0; ks < 4; ++ks) { bf16x8 a = *(const bf16x8*)(rp + 32 * ks + 8 * fq); if (!ok) a = zero8(); s1 = mfma16(a, Qf[ks], s1); } }
#pragma unroll
        for (int i = 0; i < 4; ++i) { const int kpe = k0 + 4 * fq + i, df = pq - kpe;
            const bool v0 = (kpe >= 0) && (df >= 0) && (df <= 128), v1 = (kpe + 16 >= 0) && (df - 16 >= 0) && (df - 16 <= 128);
            s0[i] = v0 ? __builtin_amdgcn_exp2f(s0[i] - Mb) : 0.f; s1[i] = v1 ? __builtin_amdgcn_exp2f(s1[i] - Mb) : 0.f; lsum += s0[i] + s1[i]; }
        const bf16x8 pb = pack8(s0, s1);
        const int g0 = k0 + 4 * fq, g1 = g0 + 16; const bool ok0 = (g0 >= 0) && (g0 < Pn), ok1 = (g1 >= 0) && (g1 < Pn);
#pragma unroll
        for (int dt = 0; dt < 8; ++dt) { const bf16_t* vp = vtb + (size_t)(16 * dt + fr) * S_ + rd * Pn;
            s16x4 lo = zero4(), hi = zero4(); if (ok0) lo = *(const s16x4*)(vp + g0); if (ok1) hi = *(const s16x4*)(vp + g1);
            oacc[dt] = mfma16(cat4(lo, hi), pb, oacc[dt]);
            if (dt == 3) __builtin_amdgcn_sched_barrier(0); }
    }
}
DI void p3_dil(const Params& P, int l, int b, int h, int r, int a0) {
    const int lane = tidl() & 63, fr = lane & 15, fq = lane >> 4;
    const float mgq = wmaxf(fmaxf(fabsf(P.dqg[l * 128 + lane]), fabsf(P.dqg[l * 128 + 64 + lane]))), mgk = wmaxf(fmaxf(fabsf(P.dkg[l * 128 + lane]), fabsf(P.dkg[l * 128 + 64 + lane])));
    const float Mb = 11.313708498984761f * LOG2E * mgq * mgk;
    const int tq = 16 * (a0 + fr) + r; const size_t tokq = (size_t)b * S_ + tq;
    bf16x8 Qf[4];
#pragma unroll
    for (int ks = 0; ks < 4; ++ks) Qf[ks] = *(const bf16x8*)(P.dq() + tokq * 512 + h * 128 + 32 * ks + 8 * fq);
    f32x4 oacc[8];
#pragma unroll
    for (int i = 0; i < 8; ++i) oacc[i] = fz4();
    float lsum = 0.f;
    const bf16_t* dkb = P.dk() + (size_t)b * S_ * 512 + h * 128; const size_t vo = ((size_t)b * 512 + h * 128) * S_;
    dil_cfg(dkb, P.Vt16() + vo, 16, 256, r, a0, 1, 5, Qf, oacc, lsum, Mb, fr, fq);
    dil_cfg(dkb, P.Vt4() + vo, 4, 1024, r & 3, 4 * a0 + (r >> 2), 4, 7, Qf, oacc, lsum, Mb, fr, fq);
    dil_cfg(dkb, P.Vt1() + vo, 1, 4096, 0, 16 * a0 + r, 16, 12, Qf, oacc, lsum, Mb, fr, fq);
    lsum += __shfl_xor(lsum, 16); lsum += __shfl_xor(lsum, 32); const float inv = 1.0f / lsum;
#pragma unroll
    for (int dt = 0; dt < 8; ++dt) { const f32x4 gv = ld4bf(P.u() + tokq * NINP + U_GD + h * 128 + dt * 16 + fq * 4); f32x4 o = oacc[dt] * inv;
        o[0] *= silu_f(gv[0]); o[1] *= silu_f(gv[1]); o[2] *= silu_f(gv[2]); o[3] *= silu_f(gv[3]);
        st4bf(P.y() + tokq * 2048 + 1536 + h * 128 + dt * 16 + fq * 4, o); }
}

DI void phase3(const Params& P, int l, unsigned char* sm, int* s_item) {
    const int tid = tidl(), wid = tid >> 6;
#ifndef P3_DYNAMIC
#define P3_DYNAMIC 0
#endif
    for (int it_ = blockIdx.x;; it_ += gridDim.x) {
        __syncthreads();
#if P3_DYNAMIC
        if (tid == 0) *s_item = (int)atomicAdd(P.ctr() + l, 1u);
        __syncthreads();
        const int idx = *s_item;
#else
        const int idx = it_;
#endif
        if (idx >= P3_NITEMS) break;
#ifndef ONLY_P3
#define ONLY_P3 -1
#endif
        if (idx < 16) { if (ONLY_P3 < 0 || ONLY_P3 == 1) p3_gla(P, idx >> 2, idx & 3, wid); }
        else if (idx < 32) { const int j = idx - 16; if (ONLY_P3 < 0 || ONLY_P3 == 2) p3_ssd(P, l, j >> 2, (j & 3) * 2 + (wid >> 2), wid & 3); }
        else if (idx < 544) { const int j = idx - 32, bh = j & 15; if (ONLY_P3 < 0 || ONLY_P3 == 3) p3_mla(P, bh >> 2, bh & 3, 31 - (j >> 4), sm); }
        else { const int j = idx - 544, bh = j >> 5, rem = j & 31; if (ONLY_P3 < 0 || ONLY_P3 == 4) p3_dil(P, l, bh >> 2, bh & 3, rem >> 1, 16 * ((rem & 1) * 8 + wid)); }
    }
}

DI void phase3b(const Params& P, int l) {
    const int tid = tidl(), wid = tid >> 6, lane = tid & 63;
    for (int row = blockIdx.x * 8 + wid; row < T_; row += gridDim.x * 8) {
        const bf16_t* up = P.u() + (size_t)row * NINP; bf16_t* yp = P.y() + (size_t)row * 2048;
#pragma unroll
        for (int h = 0; h < 4; ++h) { const float x1 = P.ogla()[(size_t)row * 512 + h * 128 + lane], x2 = P.ogla()[(size_t)row * 512 + h * 128 + 64 + lane];
            const float rs = rsqrtf(wsum(x1 * x1 + x2 * x2) * (1.0f / 128.0f) + EPS_);
            yp[h * 128 + lane] = f2bf(x1 * rs * P.gng[l * 128 + lane] * silu_f(bf2f(up[U_GA + h * 128 + lane])));
            yp[h * 128 + 64 + lane] = f2bf(x2 * rs * P.gng[l * 128 + 64 + lane] * silu_f(bf2f(up[U_GA + h * 128 + 64 + lane]))); }
#pragma unroll
        for (int g = 0; g < 2; ++g) { float v[4], ss = 0.f;
#pragma unroll
            for (int k = 0; k < 4; ++k) { const int c = g * 256 + lane + 64 * k; v[k] = P.yssd()[(size_t)row * 512 + c] * silu_f(bf2f(up[U_GB + c])); ss += v[k] * v[k]; }
            const float rs = rsqrtf(wsum(ss) * (1.0f / 256.0f) + EPS_);
#pragma unroll
            for (int k = 0; k < 4; ++k) { const int c = g * 256 + lane + 64 * k; yp[512 + c] = f2bf(v[k] * rs * P.sng[l * 512 + c]); } }
    }
}

extern __shared__ __attribute__((aligned(16))) unsigned char smem[];
__global__ __launch_bounds__(512, 2) void mk_fwd(Params Pk) {
    __shared__ int s_item;
#ifndef ONLY_S
#define ONLY_S -1
#endif
    for (int phi = Pk.ph_lo; phi <= Pk.ph_hi; ++phi) {
        if (phi > Pk.ph_lo) cg::this_grid().sync();
        Params P = Pk; int ph = phi;
        asm volatile("" : "+s"(P.ws), "+s"(P.out), "+s"(ph));
        if (ph == 0) { if (ONLY_S < 0 || ONLY_S == 9) phase0(P, smem); continue; }
        const int l = (ph - 1) / 5, s = (ph - 1) % 5;
        if (s == 0) { if (ONLY_S < 0 || ONLY_S == 0) {
            pg8::Gemm g; g.A = P.xb(); g.Bt = P.WinT() + (size_t)l * NINP * 2048; g.M = T_; g.N = NINP; g.K = 2048;
            pg8::StaticOrder so; so.init(g.M, g.N, (int)gridDim.x, (int)blockIdx.x);
            EpiIn e; e.U = P.u(); e.rowsq = P.rowsq();
            pg8::gemm_phase<EpiIn, pg8::StaticOrder>((PG8_LAS unsigned char*)smem, g, so, e); }
        } else if (s == 1) { if (ONLY_S < 0 || ONLY_S == 1) phase2(P, l, smem); }
        else if (s == 2) { if (ONLY_S < 0 || ONLY_S == 2) phase3(P, l, smem, &s_item); }
        else if (s == 3) { if (ONLY_S < 0 || ONLY_S == 3) phase3b(P, l); }
        else if (ONLY_S < 0 || ONLY_S == 4) {
            pg8::Gemm g; g.A = P.y(); g.Bt = P.WoutT() + (size_t)l * 2048 * 2048; g.M = T_; g.N = 2048; g.K = 2048;
            pg8::StaticOrder so; so.init(g.M, g.N, (int)gridDim.x, (int)blockIdx.x);
            EpiOut e; e.xin = (l == 0) ? P.x : P.out; e.xout = P.out; e.xb = P.xb(); e.rsq = (l + 1 < NLAYER) ? P.rowsq() : nullptr;
            pg8::gemm_phase<EpiOut, pg8::StaticOrder>((PG8_LAS unsigned char*)smem, g, so, e);
        }
    }
}

extern "C" void kernel_launch(void* const* d_in, const int* in_sizes, int n_in, void* d_out, int out_size, void* d_ws, size_t ws_size, hipStream_t stream) {
    (void)in_sizes; (void)n_in; (void)out_size;
    Params p{};
    p.x = (const float*)d_in[0]; p.pos = (const int*)d_in[1]; p.ln_g = (const float*)d_in[2]; p.w_in = (const float*)d_in[3]; p.w_out = (const float*)d_in[4];
    p.gw2 = (const float*)d_in[5]; p.gb = (const float*)d_in[6]; p.gng = (const float*)d_in[7]; p.cw = (const float*)d_in[8]; p.cb = (const float*)d_in[9];
    p.dtb = (const float*)d_in[10]; p.alog = (const float*)d_in[11]; p.sD = (const float*)d_in[12]; p.sng = (const float*)d_in[13]; p.qng = (const float*)d_in[14];
    p.kvng = (const float*)d_in[15]; p.wuq = (const float*)d_in[16]; p.wukv = (const float*)d_in[17]; p.qhg = (const float*)d_in[18]; p.khg = (const float*)d_in[19];
    p.dqg = (const float*)d_in[20]; p.dkg = (const float*)d_in[21];
    p.out = (float*)d_out;
    p.ws = (unsigned char*)d_ws;
    if (WS_TOTAL > ws_size) { fprintf(stderr, "workspace too small: need %zu have %zu\n", (size_t)WS_TOTAL, ws_size); return; }
    static bool attr = false;
    if (!attr) { hipFuncSetAttribute((const void*)mk_fwd, hipFuncAttributeMaxDynamicSharedMemorySize, LDS_BYTES); attr = true; }
    const int NPH = 1 + 5 * NLAYER;
#if MK_MULTI
    for (int ph = 0; ph < NPH; ++ph) { p.ph_lo = ph; p.ph_hi = ph; hipLaunchKernelGGL(mk_fwd, dim3(256), dim3(512), LDS_BYTES, stream, p); }
#else
    static int grid_blocks = 0;
    if (!grid_blocks) { int dev = 0, cus = 0, per_cu = 0; hipGetDevice(&dev); hipDeviceGetAttribute(&cus, hipDeviceAttributeMultiprocessorCount, dev);
        hipOccupancyMaxActiveBlocksPerMultiprocessor(&per_cu, mk_fwd, 512, LDS_BYTES); if (per_cu < 1) per_cu = 1; if (per_cu > 1) per_cu = 1; grid_blocks = cus * per_cu; }
    p.ph_lo = 0; p.ph_hi = NPH - 1;
    void* args[] = {&p};
    hipError_t e = hipLaunchCooperativeKernel((void*)mk_fwd, dim3(grid_blocks), dim3(512), args, LDS_BYTES, stream);
    if (e != hipSuccess) fprintf(stderr, "cooperative launch failed: %s (grid %d)\n", hipGetErrorString(e), grid_blocks);
#endif
}
```

```cpp
#include <hip/hip_runtime.h>
#include <hip/hip_cooperative_groups.h>
#include <cstdio>
#include <cstdint>
namespace cg = cooperative_groups;
#ifndef MK_MULTI
#define MK_MULTI 0
#endif
namespace pg8 {
#define PG8_LAS __attribute__((address_space(3)))
typedef unsigned short bf16_t;
typedef short bf16x8 __attribute__((ext_vector_type(8)));
typedef float f32x4 __attribute__((ext_vector_type(4)));
typedef unsigned u32x4 __attribute__((ext_vector_type(4)));
constexpr int BM = 256, BK = 64, HALF = 128, HTB = HALF * BK * 2  , STAGE_BYTES = 8 * HTB, NXCD = 8, WGM = 8;

__host__ __device__ __forceinline__ int lds_byte(int r, int c) { const int st = (r >> 4) * 2 + (c >> 5), rr = r & 15, cc = c & 31, ob = rr * 64 + cc * 2; return st * 1024 + (ob ^ (((ob >> 9) & 1) << 5)); }
__host__ __device__ __forceinline__ void stage_rc(int b, int& R, int& C) { const int st = b / 1024, sb = b % 1024, swz = sb ^ (((sb >> 9) & 1) << 5); R = (st >> 1) * 16 + swz / 64; C = (st & 1) * 32 + (swz % 64) / 2; }
__host__ __device__ __forceinline__ int perm32(int rho) { const int n = rho >> 4, i = rho & 15; return 8 * (i >> 2) + 4 * n + (i & 3); }

struct Unit { int pm, pn; };
struct Gemm { const bf16_t* A; const bf16_t* Bt; int M, N, K; };

struct StaticOrder {
    int nM, nN, nwg, G, c;
    __host__ __device__ void init(int M, int N, int G_, int c_) { nM = M / BM; nN = N / BM; nwg = nM * nN; G = G_; c = c_; }
    __host__ __device__ bool next(int i, Unit& u) const {
        const long L = (long)i * G + c; if (L >= nwg) return false;
        int wgid = (int)L; { const int q = nwg / NXCD, r = nwg % NXCD, xcd = wgid % NXCD, off = wgid / NXCD; wgid = (xcd < r ? xcd * (q + 1) : r * (q + 1) + (xcd - r) * q) + off; }
        const int nig = WGM * nN, gid = wgid / nig, fm = gid * WGM, gsz = (nM - fm) < WGM ? (nM - fm) : WGM;
        u.pm = fm + ((wgid % nig) % gsz); u.pn = (wgid % nig) / gsz; return true;
    }
    __device__ __forceinline__ void a_ready(const Unit&) const {}
    __device__ __forceinline__ void done(const Unit&) const {}
};
template <class Epi, class Sched>
__device__ __forceinline__ void gemm_phase(PG8_LAS unsigned char* lds, const Gemm g, const Sched& S, const Epi& E) {
    int tid_ = threadIdx.x; asm volatile("" : "+v"(tid_));
    const int tid = tid_, wid = __builtin_amdgcn_readfirstlane(tid >> 6), lane = tid & 63, wr = wid >> 2, wc = wid & 3, fr = lane & 15, fq = lane >> 4;
    const int K = g.K, nt = K / BK;
    unsigned voffA[2], voffB[2];
#pragma unroll
    for (int i = 0; i < 2; ++i) { int R, C; stage_rc(tid * 16 + i * 8192, R, C); const int Rb = Epi::PERM ? ((R & ~31) + perm32(R & 31)) : R;
        voffA[i] = (unsigned)(R * K + C) * 2u; voffB[i] = (unsigned)(Rb * K + C) * 2u; }
    const size_t kstep = (size_t)(BK * 2);
    const size_t hstep = (size_t)HALF * K * 2;
    const size_t tstep = 2 * hstep;
    const unsigned ldsw = (unsigned)wid * 1024u;
    const int aoff = lds_byte(wr * 64 + fr, fq * 8), boff = lds_byte(wc * 32 + fr, fq * 8);
#define PG8_SA(b, h) (((b) * 2 + (h)) * HTB)
#define PG8_SB(b, h) ((4 + (b) * 2 + (h)) * HTB)
#define PG8_STAGE(bufoff, gbase, voff) do { _Pragma("unroll") for (int _i = 0; _i < 2; ++_i) \
        __builtin_amdgcn_global_load_lds((const unsigned*)((const char*)(gbase) + (voff)[_i]), (PG8_LAS unsigned*)(lds + (bufoff) + ldsw + _i * 8192), 16, 0, 0); } while (0)
#define PG8_LDA(dst, b, h) do { _Pragma("unroll") for (int m = 0; m < 4; ++m) _Pragma("unroll") for (int k = 0; k < 2; ++k) dst[m][k] = *(const PG8_LAS bf16x8*)(lds + PG8_SA(b, h) + aoff + m * 2048 + k * 1024); } while (0)
#define PG8_LDB(dst, b, h) do { _Pragma("unroll") for (int n = 0; n < 2; ++n) _Pragma("unroll") for (int k = 0; k < 2; ++k) dst[n][k] = *(const PG8_LAS bf16x8*)(lds + PG8_SB(b, h) + boff + n * 2048 + k * 1024); } while (0)
#define PG8_MMA(ai, bj, At, Bt) do { __builtin_amdgcn_s_setprio(1); _Pragma("unroll") for (int m = 0; m < 4; ++m) _Pragma("unroll") for (int n = 0; n < 2; ++n) _Pragma("unroll") for (int k = 0; k < 2; ++k) \
        acc[ai][bj][m][n] = __builtin_amdgcn_mfma_f32_16x16x32_bf16(Bt[n][k], At[m][k], acc[ai][bj][m][n], 0, 0, 0); __builtin_amdgcn_s_setprio(0); } while (0)
#define PG8_WAIT_V(n) asm volatile("s_waitcnt vmcnt(" #n ")" ::: "memory")
#define PG8_WAIT_L(n) asm volatile("s_waitcnt lgkmcnt(" #n ")" ::: "memory")
#define PG8_BAR __builtin_amdgcn_s_barrier()
#define PG8_SCHED __builtin_amdgcn_sched_barrier(0)
    Unit cur, nxt; int ui = 0;
    if (!S.next(0, cur)) return;
    f32x4 acc[2][2][4][2];
#pragma unroll
    for (int a = 0; a < 2; ++a)
#pragma unroll
        for (int b = 0; b < 2; ++b)
#pragma unroll
            for (int m = 0; m < 4; ++m)
#pragma unroll
                for (int n = 0; n < 2; ++n) acc[a][b][m][n] = (f32x4){0.f, 0.f, 0.f, 0.f};
    bf16x8 At[4][2], B0[2][2], B1[2][2];
    const char* cA = (const char*)g.A + (size_t)cur.pm * tstep; const char* cB = (const char*)g.Bt + (size_t)cur.pn * tstep;
    S.a_ready(cur);
    PG8_STAGE(PG8_SB(0, 0), cB, voffB); PG8_STAGE(PG8_SA(0, 0), cA, voffA); PG8_STAGE(PG8_SB(0, 1), cB + hstep, voffB); PG8_STAGE(PG8_SA(0, 1), cA + hstep, voffA);
    if (wr == 1) PG8_BAR;
    PG8_WAIT_V(4); PG8_BAR;
    PG8_STAGE(PG8_SB(1, 0), cB + kstep, voffB); PG8_STAGE(PG8_SA(1, 0), cA + kstep, voffA); PG8_STAGE(PG8_SB(1, 1), cB + hstep + kstep, voffB);
    PG8_WAIT_V(6); PG8_BAR;
    for (;;) {
        const bool has_next = S.next(ui + 1, nxt);
        const char* nA = has_next ? (const char*)g.A + (size_t)nxt.pm * tstep : cA; const char* nB = has_next ? (const char*)g.Bt + (size_t)nxt.pn * tstep : cB;
        for (int t = 0; t < nt; t += 2) {
            const bool last = (t == nt - 2);
            const char* a1 = cA + (size_t)(t + 1) * kstep;
            const char* a2 = last ? nA : cA + (size_t)(t + 2) * kstep; const char* b2 = last ? nB : cB + (size_t)(t + 2) * kstep;
            const char* a3 = a2 + kstep; const char* b3 = b2 + kstep;
            if (last && has_next) S.a_ready(nxt);
            PG8_LDB(B0, 0, 0); PG8_SCHED; PG8_LDA(At, 0, 0); PG8_STAGE(PG8_SA(1, 1), a1 + hstep, voffA);
            PG8_WAIT_L(8); PG8_BAR; PG8_WAIT_L(0); PG8_MMA(0, 0, At, B0); PG8_BAR; PG8_SCHED;
            PG8_LDB(B1, 0, 1); PG8_STAGE(PG8_SB(0, 0), b2, voffB);
            PG8_BAR; PG8_WAIT_L(0); PG8_MMA(0, 1, At, B1); PG8_BAR;
            PG8_LDA(At, 0, 1); PG8_STAGE(PG8_SA(0, 0), a2, voffA);
            PG8_BAR; PG8_WAIT_L(0); PG8_MMA(1, 0, At, B0); PG8_BAR; PG8_SCHED;
            PG8_STAGE(PG8_SB(0, 1), b2 + hstep, voffB);
            PG8_WAIT_V(6); PG8_BAR; PG8_MMA(1, 1, At, B1); PG8_BAR;
            PG8_LDB(B0, 1, 0); PG8_SCHED; PG8_LDA(At, 1, 0); PG8_STAGE(PG8_SA(0, 1), a2 + hstep, voffA);
            PG8_WAIT_L(8); PG8_BAR; PG8_WAIT_L(0); PG8_MMA(0, 0, At, B0); PG8_BAR; PG8_SCHED;
            PG8_LDB(B1, 1, 1); PG8_STAGE(PG8_SB(1, 0), b3, voffB);
            PG8_BAR; PG8_WAIT_L(0); PG8_MMA(0, 1, At, B1); PG8_BAR;
            PG8_LDA(At, 1, 1); PG8_STAGE(PG8_SA(1, 0), a3, voffA);
            PG8_BAR; PG8_WAIT_L(0); PG8_MMA(1, 0, At, B0); PG8_BAR; PG8_SCHED;
            PG8_STAGE(PG8_SB(1, 1), b3 + hstep, voffB);
            PG8_WAIT_V(6); PG8_BAR; PG8_MMA(1, 1, At, B1); PG8_BAR;
        }
        if constexpr (!Epi::AFTER_DRAIN) { E(acc, cur, wr, wc, fr, fq); S.done(cur); }
        if (!has_next) break;
#pragma unroll
        for (int a = 0; a < 2; ++a)
#pragma unroll
            for (int b = 0; b < 2; ++b)
#pragma unroll
                for (int m = 0; m < 4; ++m)
#pragma unroll
                    for (int n = 0; n < 2; ++n) acc[a][b][m][n] = (f32x4){0.f, 0.f, 0.f, 0.f};
        cur = nxt; cA = nA; cB = nB; ++ui;
    }
    PG8_WAIT_V(0);
    if (wr == 0) PG8_BAR;
    PG8_BAR;
    if constexpr (Epi::AFTER_DRAIN) { E.fused(acc, cur, wr, wc, fr, fq, lds, wid, lane); S.done(cur); }
#undef PG8_SA
#undef PG8_SB
#undef PG8_STAGE
#undef PG8_LDA
#undef PG8_LDB
#undef PG8_MMA
#undef PG8_WAIT_V
#undef PG8_WAIT_L
#undef PG8_BAR
#undef PG8_SCHED
}
}

#define DI __device__ __forceinline__
using pg8::bf16_t; using pg8::bf16x8; using pg8::f32x4; using pg8::u32x4;
typedef short s16x4 __attribute__((ext_vector_type(4)));
typedef unsigned u32x2 __attribute__((ext_vector_type(2)));
typedef __bf16 bf16v2 __attribute__((ext_vector_type(2)));
constexpr int T_ = 16384, S_ = 4096, NINP = 6400, NIN = 6232, NLAYER = 4;
constexpr int U_GA = 0, U_GB = 512, U_GC = 1024, U_GD = 1536, U_AQ = 2048, U_AK = 2304, U_AV = 2560, U_ALR = 3072,
              U_XBC = 3088, U_DT = 4112, U_CQ = 4120, U_CKV = 4504, U_CKR = 4632, U_DQ = 4696, U_DK = 5208, U_DV = 5720;
constexpr float EPS_ = 1e-6f, LOG2E = 1.4426950408889634f;
constexpr int LDS_BYTES = 131072;
constexpr int P3_NITEMS = 256 + 64 + 128 + 1536;

constexpr size_t SZ_WinT = (size_t)(NLAYER*(size_t)NINP*(size_t)2048*(size_t)2), OFF_WinT = 0;
constexpr size_t SZ_WoutT = (size_t)(NLAYER*(size_t)2048*(size_t)2048*(size_t)2), OFF_WoutT = OFF_WinT + ((SZ_WinT + 255) & ~(size_t)255);
constexpr size_t SZ_WuqT = (size_t)(NLAYER*(size_t)768*(size_t)384*(size_t)2), OFF_WuqT = OFF_WoutT + ((SZ_WoutT + 255) & ~(size_t)255);
constexpr size_t SZ_WukvT = (size_t)(NLAYER*(size_t)1024*(size_t)128*(size_t)2), OFF_WukvT = OFF_WuqT + ((SZ_WuqT + 255) & ~(size_t)255);
constexpr size_t SZ_u = (size_t)(T_*(size_t)NINP*(size_t)2), OFF_u = OFF_WukvT + ((SZ_WukvT + 255) & ~(size_t)255);
constexpr size_t SZ_y = (size_t)(T_*(size_t)2048*(size_t)2), OFF_y = OFF_u + ((SZ_u + 255) & ~(size_t)255);
constexpr size_t SZ_rowsq = (size_t)(T_*(size_t)32*(size_t)4), OFF_rowsq = OFF_y + ((SZ_y + 255) & ~(size_t)255);
constexpr size_t SZ_cosM = (size_t)(T_*(size_t)32*(size_t)4), OFF_cosM = OFF_rowsq + ((SZ_rowsq + 255) & ~(size_t)255);
constexpr size_t SZ_sinM = (size_t)(T_*(size_t)32*(size_t)4), OFF_sinM = OFF_cosM + ((SZ_cosM + 255) & ~(size_t)255);
constexpr size_t SZ_cosD = (size_t)(T_*(size_t)64*(size_t)4), OFF_cosD = OFF_sinM + ((SZ_sinM + 255) & ~(size_t)255);
constexpr size_t SZ_sinD = (size_t)(T_*(size_t)64*(size_t)4), OFF_sinD = OFF_cosD + ((SZ_cosD + 255) & ~(size_t)255);
constexpr size_t SZ_Qe = (size_t)(T_*(size_t)256*(size_t)2), OFF_Qe = OFF_sinD + ((SZ_sinD + 255) & ~(size_t)255);
constexpr size_t SZ_KdT = (size_t)(T_*(size_t)256*(size_t)2), OFF_KdT = OFF_Qe + ((SZ_Qe + 255) & ~(size_t)255);
constexpr size_t SZ_gvT = (size_t)(T_*(size_t)512*(size_t)2), OFF_gvT = OFF_KdT + ((SZ_KdT + 255) & ~(size_t)255);
constexpr size_t SZ_dec = (size_t)((T_/16)*(size_t)256*(size_t)4), OFF_dec = OFF_gvT + ((SZ_gvT + 255) & ~(size_t)255);
constexpr size_t SZ_ogla = (size_t)(T_*(size_t)512*(size_t)4), OFF_ogla = OFF_dec + ((SZ_dec + 255) & ~(size_t)255);
constexpr size_t SZ_yssd = (size_t)(T_*(size_t)512*(size_t)4), OFF_yssd = OFF_ogla + ((SZ_ogla + 255) & ~(size_t)255);
constexpr size_t SZ_xs = (size_t)(T_*(size_t)512*(size_t)2), OFF_xs = OFF_yssd + ((SZ_yssd + 255) & ~(size_t)255);
constexpr size_t SZ_Bm = (size_t)(T_*(size_t)256*(size_t)2), OFF_Bm = OFF_xs + ((SZ_xs + 255) & ~(size_t)255);
constexpr size_t SZ_Cm = (size_t)(T_*(size_t)256*(size_t)2), OFF_Cm = OFF_Bm + ((SZ_Bm + 255) & ~(size_t)255);
constexpr size_t SZ_BmT = (size_t)(T_*(size_t)1024*(size_t)2), OFF_BmT = OFF_Cm + ((SZ_Cm + 255) & ~(size_t)255);
constexpr size_t SZ_XdT = (size_t)(T_*(size_t)1024*(size_t)2), OFF_XdT = OFF_BmT + ((SZ_BmT + 255) & ~(size_t)255);
constexpr size_t SZ_XdtT = (size_t)(T_*(size_t)512*(size_t)2), OFF_XdtT = OFF_XdT + ((SZ_XdT + 255) & ~(size_t)255);
constexpr size_t SZ_Acs = (size_t)(T_*(size_t)8*(size_t)4), OFF_Acs = OFF_XdtT + ((SZ_XdtT + 255) & ~(size_t)255);
constexpr size_t SZ_Qc = (size_t)(T_*(size_t)768*(size_t)2), OFF_Qc = OFF_Acs + ((SZ_Acs + 255) & ~(size_t)255);
constexpr size_t SZ_Kc = (size_t)(T_*(size_t)768*(size_t)2), OFF_Kc = OFF_Qc + ((SZ_Qc + 255) & ~(size_t)255);
constexpr size_t SZ_Vct = (size_t)(T_*(size_t)512*(size_t)2), OFF_Vct = OFF_Kc + ((SZ_Kc + 255) & ~(size_t)255);
constexpr size_t SZ_dq = (size_t)(T_*(size_t)512*(size_t)2), OFF_dq = OFF_Vct + ((SZ_Vct + 255) & ~(size_t)255);
constexpr size_t SZ_dk = (size_t)(T_*(size_t)512*(size_t)2), OFF_dk = OFF_dq + ((SZ_dq + 255) & ~(size_t)255);
constexpr size_t SZ_Vt1 = (size_t)(T_*(size_t)512*(size_t)2), OFF_Vt1 = OFF_dk + ((SZ_dk + 255) & ~(size_t)255);
constexpr size_t SZ_Vt4 = (size_t)(T_*(size_t)512*(size_t)2), OFF_Vt4 = OFF_Vt1 + ((SZ_Vt1 + 255) & ~(size_t)255);
constexpr size_t SZ_Vt16 = (size_t)(T_*(size_t)512*(size_t)2), OFF_Vt16 = OFF_Vt4 + ((SZ_Vt4 + 255) & ~(size_t)255);
constexpr size_t SZ_ctr = (size_t)(256 + 3456*(size_t)4 + 65536 + 262144), OFF_ctr = OFF_Vt16 + ((SZ_Vt16 + 255) & ~(size_t)255);
constexpr size_t WS_TOTAL = OFF_ctr + ((SZ_ctr + 255) & ~(size_t)255);
struct Params {
    const float *x, *ln_g, *w_in, *w_out, *gw2, *gb, *gng, *cw, *cb, *dtb, *alog, *sD, *sng, *qng, *kvng, *wuq, *wukv, *qhg, *khg, *dqg, *dkg;
    const int* pos;
    float* out;
    unsigned char* ws;
    int ph_lo, ph_hi;
    __device__ __forceinline__ bf16_t* WinT() const { return (bf16_t*)(ws + OFF_WinT); }
    __device__ __forceinline__ bf16_t* WoutT() const { return (bf16_t*)(ws + OFF_WoutT); }
    __device__ __forceinline__ bf16_t* WuqT() const { return (bf16_t*)(ws + OFF_WuqT); }
    __device__ __forceinline__ bf16_t* WukvT() const { return (bf16_t*)(ws + OFF_WukvT); }
    __device__ __forceinline__ bf16_t* u() const { return (bf16_t*)(ws + OFF_u); }
    __device__ __forceinline__ bf16_t* y() const { return (bf16_t*)(ws + OFF_y); }
    __device__ __forceinline__ float* rowsq() const { return (float*)(ws + OFF_rowsq); }
    __device__ __forceinline__ float* cosM() const { return (float*)(ws + OFF_cosM); }
    __device__ __forceinline__ float* sinM() const { return (float*)(ws + OFF_sinM); }
    __device__ __forceinline__ float* cosD() const { return (float*)(ws + OFF_cosD); }
    __device__ __forceinline__ float* sinD() const { return (float*)(ws + OFF_sinD); }
    __device__ __forceinline__ bf16_t* Qe() const { return (bf16_t*)(ws + OFF_Qe); }
    __device__ __forceinline__ bf16_t* KdT() const { return (bf16_t*)(ws + OFF_KdT); }
    __device__ __forceinline__ bf16_t* gvT() const { return (bf16_t*)(ws + OFF_gvT); }
    __device__ __forceinline__ float* dec() const { return (float*)(ws + OFF_dec); }
    __device__ __forceinline__ bf16_t* ogla() const { return (bf16_t*)(ws + OFF_ogla); }
    __device__ __forceinline__ float* yssd() const { return (float*)(ws + OFF_yssd); }
    __device__ __forceinline__ bf16_t* xs() const { return (bf16_t*)(ws + OFF_xs); }
    __device__ __forceinline__ bf16_t* Bm() const { return (bf16_t*)(ws + OFF_Bm); }
    __device__ __forceinline__ bf16_t* Cm() const { return (bf16_t*)(ws + OFF_Cm); }
    __device__ __forceinline__ bf16_t* Pv() const { return (bf16_t*)(ws + OFF_XdT); }
    __device__ __forceinline__ bf16_t* Od4() const { return (bf16_t*)(ws + OFF_BmT); }
    __device__ __forceinline__ bf16_t* Od16() const { return (bf16_t*)(ws + OFF_BmT + SZ_BmT / 2); }
    __device__ __forceinline__ bf16_t* Sg() const { return (bf16_t*)(ws + OFF_XdT); }
    __device__ __forceinline__ bf16_t* XdtT() const { return (bf16_t*)(ws + OFF_XdtT); }
    __device__ __forceinline__ float* Acs() const { return (float*)(ws + OFF_Acs); }
    __device__ __forceinline__ bf16_t* Qc() const { return (bf16_t*)(ws + OFF_Qc); }
    __device__ __forceinline__ bf16_t* Kc() const { return (bf16_t*)(ws + OFF_Kc); }
    __device__ __forceinline__ bf16_t* Vct() const { return (bf16_t*)(ws + OFF_Vct); }
    __device__ __forceinline__ bf16_t* dq() const { return (bf16_t*)(ws + OFF_dq); }
    __device__ __forceinline__ bf16_t* dk() const { return (bf16_t*)(ws + OFF_dk); }
    __device__ __forceinline__ bf16_t* Vt1() const { return (bf16_t*)(ws + OFF_Vt1); }
    __device__ __forceinline__ bf16_t* Vt4() const { return (bf16_t*)(ws + OFF_Vt4); }
    __device__ __forceinline__ bf16_t* Vt16() const { return (bf16_t*)(ws + OFF_Vt16); }
    __device__ __forceinline__ unsigned* ctr() const { return (unsigned*)(ws + OFF_ctr); }
    __device__ __forceinline__ unsigned* bar() const { return (unsigned*)(ws + OFF_ctr + 256); }
    __device__ __forceinline__ float* rstd() const { return (float*)(ws + OFF_ctr + 256 + 3456 * 4); }
    __device__ __forceinline__ float* Dt() const { return (float*)(ws + OFF_ctr + 256 + 3456 * 4 + 65536); }
    __device__ __forceinline__ bf16_t* Lg() const { return (bf16_t*)(ws + OFF_yssd); }
    __device__ __forceinline__ bf16_t* Sst() const { return (bf16_t*)(ws + OFF_yssd); }
    __device__ __forceinline__ float* ldp() const { return (float*)(ws + OFF_yssd + SZ_yssd / 2); }
    __device__ __forceinline__ bf16_t* xb() const { return (bf16_t*)(ws + OFF_ogla); }
};

DI const bf16_t* launder_p(const bf16_t* p) { int z = 0; asm volatile("" : "+v"(z)); return p + z; }
DI int tidl() { int t = threadIdx.x; asm volatile("" : "+v"(t)); return t; }
DI float bf2f(bf16_t h) { return __uint_as_float((unsigned)h << 16); }
DI unsigned pk2(float lo, float hi) { bf16v2 v = {(__bf16)lo, (__bf16)hi}; return __builtin_bit_cast(unsigned, v); }
DI bf16_t f2bf(float x) { return (bf16_t)(pk2(x, 0.f) & 0xffffu); }
DI float lo2f(unsigned w) { return __uint_as_float(w << 16); }
DI float hi2f(unsigned w) { return __uint_as_float(w & 0xffff0000u); }
DI float wsum(float v) {
#pragma unroll
    for (int o = 32; o; o >>= 1) v += __shfl_xor(v, o);
    return v; }
DI float wmaxf(float v) {
#pragma unroll
    for (int o = 32; o; o >>= 1) v = fmaxf(v, __shfl_xor(v, o));
    return v; }
DI float silu_f(float x) { return x / (1.f + __expf(-x)); }
DI bf16x8 pack8(f32x4 a, f32x4 b) { u32x4 w; w.x = pk2(a[0], a[1]); w.y = pk2(a[2], a[3]); w.z = pk2(b[0], b[1]); w.w = pk2(b[2], b[3]); return __builtin_bit_cast(bf16x8, w); }
DI bf16x8 cat4(s16x4 a, s16x4 b) { bf16x8 r; r[0] = a[0]; r[1] = a[1]; r[2] = a[2]; r[3] = a[3]; r[4] = b[0]; r[5] = b[1]; r[6] = b[2]; r[7] = b[3]; return r; }
DI bf16x8 zero8() { bf16x8 r = {0, 0, 0, 0, 0, 0, 0, 0}; return r; }
DI s16x4 zero4() { s16x4 r = {0, 0, 0, 0}; return r; }
DI f32x4 fz4() { f32x4 r = {0.f, 0.f, 0.f, 0.f}; return r; }
DI f32x4 mfma16(bf16x8 a, bf16x8 b, f32x4 c) { return __builtin_amdgcn_mfma_f32_16x16x32_bf16(a, b, c, 0, 0, 0); }
DI bf16x8 ldperm(const bf16_t* p, int fq) { return cat4(*(const s16x4*)(p + 4 * fq), *(const s16x4*)(p + 16 + 4 * fq)); }
DI f32x4 ld4bf(const bf16_t* p) { u32x2 w = *(const u32x2*)p; f32x4 r; r[0] = lo2f(w.x); r[1] = hi2f(w.x); r[2] = lo2f(w.y); r[3] = hi2f(w.y); return r; }
DI void st4bf(bf16_t* p, f32x4 v) { u32x2 w; w.x = pk2(v[0], v[1]); w.y = pk2(v[2], v[3]); *(u32x2*)p = w; }

struct EpiIn {
    static constexpr bool PERM = true, AFTER_DRAIN = false;
    bf16_t* U; const float* rstd;
    DI void operator()(const f32x4 (&acc)[2][2][4][2], const pg8::Unit& u, int wr, int wc, int fr, int fq) const {
        const int row0 = u.pm * 256 + wr * 64 + fr, col0 = u.pn * 256 + wc * 32 + 8 * fq;
        float rs[2][4];
#pragma unroll
        for (int ai = 0; ai < 2; ++ai)
#pragma unroll
            for (int m = 0; m < 4; ++m) rs[ai][m] = rstd[row0 + ai * 128 + m * 16];
#pragma unroll
        for (int ai = 0; ai < 2; ++ai)
#pragma unroll
            for (int m = 0; m < 4; ++m) {
                const float r = rs[ai][m];
                bf16_t* rowp = U + (size_t)(row0 + ai * 128 + m * 16) * NINP + col0;
#pragma unroll
                for (int bj = 0; bj < 2; ++bj) {
                    const f32x4 v0 = acc[ai][bj][m][0] * r, v1 = acc[ai][bj][m][1] * r;
                    u32x4 w; w.x = pk2(v0[0], v0[1]); w.y = pk2(v0[2], v0[3]); w.z = pk2(v1[0], v1[1]); w.w = pk2(v1[2], v1[3]);
                    if (col0 + bj * 128 < NIN) *(u32x4*)(rowp + bj * 128) = w; } }
    }
};
struct EpiOut {
    static constexpr bool PERM = false, AFTER_DRAIN = false;
    const float* xin; float* xout; bf16_t* xb; float* rsq;
    DI void operator()(const f32x4 (&acc)[2][2][4][2], const pg8::Unit& u, int wr, int wc, int fr, int fq) const {
        const int row0 = u.pm * 256 + wr * 64 + fr, col0 = u.pn * 256 + wc * 32 + 4 * fq;
#pragma unroll
        for (int ai = 0; ai < 2; ++ai) {
            f32x4 xv[4][2][2];
#pragma unroll
            for (int m = 0; m < 4; ++m)
#pragma unroll
                for (int bj = 0; bj < 2; ++bj)
#pragma unroll
                    for (int n = 0; n < 2; ++n) xv[m][bj][n] = *(const f32x4*)(xin + (size_t)(row0 + ai * 128 + m * 16) * 2048 + col0 + bj * 128 + n * 16);
            __builtin_amdgcn_sched_barrier(0);
#pragma unroll
            for (int m = 0; m < 4; ++m) {
                const int row = row0 + ai * 128 + m * 16; float ss = 0.f;
#pragma unroll
                for (int bj = 0; bj < 2; ++bj)
#pragma unroll
                    for (int n = 0; n < 2; ++n) {
                        const size_t o = (size_t)row * 2048 + col0 + bj * 128 + n * 16;
                        const f32x4 v = xv[m][bj][n] + acc[ai][bj][m][n];
                        *(f32x4*)(xout + o) = v;
                        if (rsq) { st4bf(xb + o, v); ss += v[0] * v[0] + v[1] * v[1] + v[2] * v[2] + v[3] * v[3]; } }
                if (rsq) { ss += __shfl_xor(ss, 16); ss += __shfl_xor(ss, 32); if (fq == 0) rsq[(size_t)row * 32 + u.pn * 4 + wc] = ss; } } }
    }
};

struct TrJob { const float* src; const float* g; bf16_t* dst; int K, N, k0, n0; };
DI TrJob tr_decode(const Params& P, int it) {
    constexpr int T_IN = 32 * 100, T_OUT = 32 * 32, T_UQ = 6 * 12, T_UKV = 2 * 16, T_L = T_IN + T_OUT + T_UQ + T_UKV;
    TrJob j; const int l = it / T_L; int r = it % T_L;
    if (r < T_IN) { j.src = P.w_in + (size_t)l * 2048 * NIN; j.K = 2048; j.N = NIN; j.g = P.ln_g + l * 2048; j.dst = P.WinT() + (size_t)l * NINP * 2048; j.k0 = (r / 100) * 64; j.n0 = (r % 100) * 64; }
    else if ((r -= T_IN) < T_OUT) { j.src = P.w_out + (size_t)l * 2048 * 2048; j.K = 2048; j.N = 2048; j.g = nullptr; j.dst = P.WoutT() + (size_t)l * 2048 * 2048; j.k0 = (r / 32) * 64; j.n0 = (r % 32) * 64; }
    else if ((r -= T_OUT) < T_UQ) { j.src = P.wuq + (size_t)l * 384 * 768; j.K = 384; j.N = 768; j.g = P.qng + l * 384; j.dst = P.WuqT() + (size_t)l * 768 * 384; j.k0 = (r / 12) * 64; j.n0 = (r % 12) * 64; }
    else { r -= T_UQ; j.src = P.wukv + (size_t)l * 128 * 1024; j.K = 128; j.N = 1024; j.g = P.kvng + l * 128; j.dst = P.WukvT() + (size_t)l * 1024 * 128; j.k0 = (r / 16) * 64; j.n0 = (r % 16) * 64; }
    return j;
}
DI void convert_weights(const Params& P, unsigned char* sm, int t_lo, int t_hi, int bid, int G) {
    float* tile = (float*)sm;
    const int tid = tidl();
    for (int it4 = t_lo + bid * 4; it4 < t_hi; it4 += G * 4) {
        float v[4][8];
#pragma unroll
        for (int q = 0; q < 4; ++q) { const int it = it4 + q; if (it < t_hi) { const TrJob j = tr_decode(P, it);
#pragma unroll
            for (int i = 0; i < 8; ++i) { const int r = (tid >> 6) + 8 * i, nn = tid & 63, k = j.k0 + r, n = j.n0 + nn;
                v[q][i] = (n < j.N) ? j.src[(size_t)k * j.N + n] * (j.g ? j.g[k] : 1.f) : 0.f; } } }
#pragma unroll
        for (int q = 0; q < 4; ++q)
#pragma unroll
            for (int i = 0; i < 8; ++i) tile[q * 4160 + ((tid >> 6) + 8 * i) * 65 + (tid & 63)] = v[q][i];
        __syncthreads();
#pragma unroll
        for (int q = 0; q < 4; ++q) { const int it = it4 + q; if (it < t_hi) { const TrJob j = tr_decode(P, it); const float* tq = tile + q * 4160;
            const int n = tid >> 3, kg = (tid & 7) * 8; u32x4 w;
            w.x = pk2(tq[(kg + 0) * 65 + n], tq[(kg + 1) * 65 + n]); w.y = pk2(tq[(kg + 2) * 65 + n], tq[(kg + 3) * 65 + n]);
            w.z = pk2(tq[(kg + 4) * 65 + n], tq[(kg + 5) * 65 + n]); w.w = pk2(tq[(kg + 6) * 65 + n], tq[(kg + 7) * 65 + n]);
            *(u32x4*)(j.dst + (size_t)(j.n0 + n) * j.K + j.k0 + kg) = w; } }
        __syncthreads();
    }
}
constexpr int TILES_PER_LAYER = 32 * 100 + 32 * 32 + 6 * 12 + 2 * 16;
DI void phase0(const Params& P, unsigned char* sm) {
    const int tid = tidl(), wid = tid >> 6, lane = tid & 63, G = gridDim.x, bid = blockIdx.x;
    convert_weights(P, sm, 0, TILES_PER_LAYER, bid, G);
    for (int row = bid * 8 + wid; row < T_; row += G * 8) {
        const float* xr = P.x + (size_t)row * 2048; float ss = 0.f;
#pragma unroll
        for (int i = 0; i < 8; ++i) { const int c = lane * 4 + 256 * i; const f32x4 v = *(const f32x4*)(xr + c);
            ss += v[0] * v[0] + v[1] * v[1] + v[2] * v[2] + v[3] * v[3]; st4bf(P.xb() + (size_t)row * 2048 + c, v); }
        ss = wsum(ss); if (lane == 0) P.rstd()[row] = rsqrtf(ss * (1.0f / 2048.0f) + EPS_);
    }
    const int gtid = bid * 512 + tid, gn = G * 512;
    if (gtid < 16) P.ctr()[gtid] = 0u;
    for (int e = gtid; e < T_ * 96; e += gn) {
        const int tok = e / 96, j = e % 96; const double pos = (double)P.pos[tok];
        const bool isM = j < 32; const int jj = isM ? j : j - 32;
        const double invf = (double)expf((-9.210340372f * (float)jj) * (isM ? (2.0f / 64.0f) : (2.0f / 128.0f)));
        double ang = pos * invf; const double kq = rint(ang * 0.15915494309189535); ang = ang - kq * 6.283185307179586;
        const float a = (float)ang; const float c = cosf(a), s = sinf(a);
        if (isM) { P.cosM()[tok * 32 + jj] = c; P.sinM()[tok * 32 + jj] = s; } else { P.cosD()[tok * 64 + jj] = c; P.sinD()[tok * 64 + jj] = s; }
    }
}

DI void tr_out(const bf16_t* tile, int ld, int Wlog, bf16_t* dst, int t0, int d) {
    const int run = 64 / d, W = 1 << Wlog;
    for (int unit = tidl(); unit < W * 8; unit += 512) {
        const int c = unit & (W - 1), pi0 = (unit >> Wlog) * 8; unsigned v[8];
#pragma unroll
        for (int e = 0; e < 8; ++e) { const int pi = pi0 + e, rd = pi / run, off = pi % run; v[e] = tile[(off * d + rd) * ld + c]; }
        u32x4 w; w.x = v[0] | (v[1] << 16); w.y = v[2] | (v[3] << 16); w.z = v[4] | (v[5] << 16); w.w = v[6] | (v[7] << 16);
        *(u32x4*)(dst + (size_t)c * S_ + t0 + pi0) = w; }
}

DI void p2_gla(const Params& P, int l, int b, int t0, unsigned char* sm) {
    bf16_t* QeL = (bf16_t*)sm; bf16_t* KeL = (bf16_t*)(sm + 33792); bf16_t* vL = (bf16_t*)sm; bf16_t* KdL = (bf16_t*)(sm + 67584);
    float* attnL = (float*)(sm + 101376); float* alrL = (float*)(sm + 117760); float* decL = (float*)(sm + 121856);
    const int tid = tidl(); const size_t tokb = (size_t)b * S_ + t0;
    for (int e = tid; e < 1024; e += 512) alrL[e] = bf2f(P.u()[(tokb + (e >> 4)) * NINP + U_ALR + (e & 15)]);
    __syncthreads();
    {
        const int c = tid & 255, half = tid >> 8;
        float w2r[16];
#pragma unroll
        for (int r = 0; r < 16; ++r) w2r[r] = P.gw2[(l * 16 + r) * 256 + c];
        const float bias = P.gb[l * 256 + c];
#pragma unroll
        for (int chh = 0; chh < 2; ++chh) {
            const int ch = half * 2 + chh; float bc[16]; float run = 0.f;
            bf16_t qr[16], kr[16];
#pragma unroll
            for (int i = 0; i < 16; ++i) { const size_t tok = tokb + ch * 16 + i; qr[i] = P.u()[tok * NINP + U_AQ + c]; kr[i] = P.u()[tok * NINP + U_AK + c]; }
#pragma unroll
            for (int i = 0; i < 16; ++i) { const int tl = ch * 16 + i; float pre = bias;
#pragma unroll
                for (int r = 0; r < 16; ++r) pre += alrL[tl * 16 + r] * w2r[r];
                const float ls = fminf(pre, 0.f) - __logf(1.0f + __expf(-fabsf(pre))); run += ls * (1.0f / 16.0f); bc[i] = run; }
            const float bl = run;
#pragma unroll
            for (int i = 0; i < 16; ++i) { const int tl = ch * 16 + i; const size_t tok = tokb + tl;
                const float q = bf2f(qr[i]), k = bf2f(kr[i]);
                const bf16_t qeb = f2bf(q * 0.125f * __expf(bc[i]));
                P.Qe()[tok * 256 + c] = qeb; QeL[tl * 264 + c] = qeb; KeL[tl * 264 + c] = f2bf(k * __expf(-bc[i])); KdL[tl * 264 + c] = f2bf(k * __expf(bl - bc[i])); }
            { const float db = __expf(bl); P.dec()[((size_t)b * 256 + (t0 >> 4) + ch) * 256 + c] = db; decL[ch * 256 + c] = db; }
        }
    }
    __syncthreads();
    if (tid < 256) P.Dt()[((size_t)b * 64 + (t0 >> 6)) * 256 + tid] = (decL[tid] * decL[256 + tid]) * (decL[512 + tid] * decL[768 + tid]);
#pragma unroll 2
    for (int rr = 0; rr < 8; ++rr) { const int e = tid + 512 * rr, combo = e >> 8, i = (e >> 4) & 15, j = e & 15, ch = combo >> 2, h = combo & 3;
        float a = 0.f;
        if (j <= i) { const bf16_t* qp = QeL + (ch * 16 + i) * 264 + h * 64; const bf16_t* kp = KeL + (ch * 16 + j) * 264 + h * 64;
#pragma unroll
            for (int d8 = 0; d8 < 8; ++d8) { const u32x4 qv = *(const u32x4*)(qp + d8 * 8), kv = *(const u32x4*)(kp + d8 * 8);
                a += lo2f(qv.x) * lo2f(kv.x) + hi2f(qv.x) * hi2f(kv.x) + lo2f(qv.y) * lo2f(kv.y) + hi2f(qv.y) * hi2f(kv.y)
                   + lo2f(qv.z) * lo2f(kv.z) + hi2f(qv.z) * hi2f(kv.z) + lo2f(qv.w) * lo2f(kv.w) + hi2f(qv.w) * hi2f(kv.w); } }
        attnL[e] = a; }
    tr_out(KdL, 264, 8, P.KdT() + (size_t)b * 256 * S_, t0, 1);
    __syncthreads();
    for (int e = tid; e < 4096; e += 512) { const int tl = e >> 6, c8 = (e & 63) * 8; *(u32x4*)(vL + tl * 520 + c8) = *(const u32x4*)(P.u() + (tokb + tl) * NINP + U_AV + c8); }
    __syncthreads();
    { const int cc = tid, h = cc >> 7;
      for (int ch = 0; ch < 4; ++ch) { float vv[16];
#pragma unroll
          for (int j = 0; j < 16; ++j) vv[j] = bf2f(vL[(ch * 16 + j) * 520 + cc]);
          const float* ap = attnL + (ch * 4 + h) * 256;
#pragma unroll
          for (int i = 0; i < 16; ++i) { float o = 0.f;
#pragma unroll
              for (int j4 = 0; j4 < 4; ++j4) { const f32x4 av = *(const f32x4*)(ap + i * 16 + j4 * 4); o += av[0] * vv[j4 * 4] + av[1] * vv[j4 * 4 + 1] + av[2] * vv[j4 * 4 + 2] + av[3] * vv[j4 * 4 + 3]; }
              P.ogla()[(tokb + ch * 16 + i) * 512 + cc] = f2bf(o); } } }
    tr_out(vL, 520, 9, P.gvT() + (size_t)b * 512 * S_, t0, 1);
    {
        const int w = tid >> 6, lane = tid & 63, fr = lane & 15, fq = lane >> 4;
#pragma unroll 1
        for (int h = 0; h < 4; ++h) { f32x4 S[4] = {fz4(), fz4(), fz4(), fz4()};
#pragma unroll 1
            for (int ch = 0; ch < 4; ++ch) {
                if (ch > 0) {
#pragma unroll
                    for (int kt = 0; kt < 4; ++kt) S[kt] = S[kt] * *(const f32x4*)(decL + ch * 256 + h * 64 + 16 * kt + 4 * fq); }
                bf16x8 vb = zero8(), ka[4] = {zero8(), zero8(), zero8(), zero8()};
                if (fq < 2) {
#pragma unroll
                    for (int j = 0; j < 8; ++j) { const int tl = ch * 16 + 8 * fq + j; vb[j] = (short)vL[tl * 520 + h * 128 + 16 * w + fr];
#pragma unroll
                        for (int kt = 0; kt < 4; ++kt) ka[kt][j] = (short)KdL[tl * 264 + h * 64 + 16 * kt + fr]; } }
#pragma unroll
                for (int kt = 0; kt < 4; ++kt) S[kt] = mfma16(ka[kt], vb, S[kt]); }
#pragma unroll
            for (int kt = 0; kt < 4; ++kt) st4bf(P.Lg() + (((((size_t)(b * 64 + (t0 >> 6)) * 4 + h) * 4 + kt) * 8 + w) * 256) + lane * 4, S[kt]); }
    }
    __syncthreads();
}

DI void p2_ssd(const Params& P, int l, int b, int t0, unsigned char* sm) {
    bf16_t* xT = (bf16_t*)sm; bf16_t* bT = (bf16_t*)(sm + 73728); float* dtL = (float*)(sm + 110592); float* facL = (float*)(sm + 112640);
    const int tid = tidl(), wid = tid >> 6, lane = tid & 63, fr = lane & 15, fq = lane >> 4; const size_t tokb = (size_t)b * S_ + t0; const int cidx = t0 >> 6;
    { const int h = wid; const float raw = bf2f(P.u()[(tokb + lane) * NINP + U_DT + h]) + P.dtb[l * 8 + h];
      const float dtv = fmaxf(raw, 0.f) + __logf(1.0f + __expf(-fabsf(raw)));
      const float a = -dtv * __expf(P.alog[l * 8 + h]);
      float cs = a;
#pragma unroll
      for (int o = 1; o < 64; o <<= 1) { const float t = __shfl_up(cs, o); if (lane >= o) cs += t; }
      const float last = __shfl(cs, 63);
      dtL[h * 64 + lane] = dtv; facL[h * 64 + lane] = __expf(last - cs);
      P.Acs()[(((size_t)b * 64 + cidx) * 8 + h) * 64 + lane] = cs; }
    __syncthreads();
    { const int ch0 = 2 * tid; float w0[4], w1[4];
#pragma unroll
      for (int j = 0; j < 4; ++j) { w0[j] = P.cw[(l * 4 + j) * 1024 + ch0]; w1[j] = P.cw[(l * 4 + j) * 1024 + ch0 + 1]; }
      const float cb0 = P.cb[l * 1024 + ch0], cb1 = P.cb[l * 1024 + ch0 + 1];
      float a0 = 0.f, a1 = 0.f, a2 = 0.f, b0 = 0.f, b1 = 0.f, b2 = 0.f;
      if (t0 > 0) { const unsigned v0 = *(const unsigned*)(P.u() + (tokb - 3) * NINP + U_XBC + ch0), v1 = *(const unsigned*)(P.u() + (tokb - 2) * NINP + U_XBC + ch0), v2 = *(const unsigned*)(P.u() + (tokb - 1) * NINP + U_XBC + ch0);
          a0 = lo2f(v0); b0 = hi2f(v0); a1 = lo2f(v1); b1 = hi2f(v1); a2 = lo2f(v2); b2 = hi2f(v2); }
      const int role = ch0 < 512 ? 0 : (ch0 < 768 ? 1 : 2), hh = (ch0 >> 6) & 7;
#pragma unroll 1
      for (int tb = 0; tb < 64; tb += 16) { unsigned vv[16];
#pragma unroll
      for (int q = 0; q < 16; ++q) vv[q] = *(const unsigned*)(P.u() + (tokb + tb + q) * NINP + U_XBC + ch0);
#pragma unroll
      for (int q = 0; q < 16; ++q) { const int tl = tb + q; const unsigned v = vv[q]; const float x0 = lo2f(v), x1 = hi2f(v);
          const float c0 = cb0 + a0 * w0[0] + a1 * w0[1] + a2 * w0[2] + x0 * w0[3], c1 = cb1 + b0 * w1[0] + b1 * w1[1] + b2 * w1[2] + x1 * w1[3];
          a0 = a1; a1 = a2; a2 = x0; b0 = b1; b1 = b2; b2 = x1;
          const float s0 = silu_f(c0), s1 = silu_f(c1);
          if (role == 0) { const float dtv = dtL[hh * 64 + tl];
              *(unsigned*)(P.xs() + (tokb + tl) * 512 + ch0) = pk2(s0, s1); xT[ch0 * 72 + tl] = f2bf(s0 * dtv); xT[(ch0 + 1) * 72 + tl] = f2bf(s1 * dtv); }
          else if (role == 1) { const unsigned w = pk2(s0, s1); *(unsigned*)(P.Bm() + (tokb + tl) * 256 + (ch0 - 512)) = w; bT[(ch0 - 512) * 72 + tl] = (bf16_t)(w & 0xffffu); bT[(ch0 - 511) * 72 + tl] = (bf16_t)(w >> 16); }
          else { *(unsigned*)(P.Cm() + (tokb + tl) * 256 + (ch0 - 768)) = pk2(s0, s1); } } } }
    __syncthreads();
    for (int unit = tid; unit < 4096; unit += 512) { const int c = unit >> 3, g8 = (unit & 7) * 8;
        *(u32x4*)(P.XdtT() + ((size_t)b * 512 + c) * S_ + t0 + g8) = *(const u32x4*)(xT + c * 72 + g8); }
    {
        const int h = wid, g = h >> 2;
#pragma unroll 1
        for (int pt = 0; pt < 4; ++pt) {
            bf16x8 bx[2];
#pragma unroll
            for (int ks = 0; ks < 2; ++ks) { const u32x4 raw = *(const u32x4*)(xT + (h * 64 + 16 * pt + fr) * 72 + 32 * ks + 8 * fq);
                const float* fp = facL + h * 64 + 32 * ks + 8 * fq; const f32x4 f0 = *(const f32x4*)fp, f1 = *(const f32x4*)(fp + 4);
                u32x4 w; w.x = pk2(lo2f(raw.x) * f0[0], hi2f(raw.x) * f0[1]); w.y = pk2(lo2f(raw.y) * f0[2], hi2f(raw.y) * f0[3]);
                w.z = pk2(lo2f(raw.z) * f1[0], hi2f(raw.z) * f1[1]); w.w = pk2(lo2f(raw.w) * f1[2], hi2f(raw.w) * f1[3]);
                bx[ks] = __builtin_bit_cast(bf16x8, w); }
#pragma unroll
            for (int nt = 0; nt < 8; ++nt) { f32x4 acc = fz4();
#pragma unroll
                for (int ks = 0; ks < 2; ++ks) acc = mfma16(*(const bf16x8*)(bT + (g * 128 + 16 * nt + fr) * 72 + 32 * ks + 8 * fq), bx[ks], acc);
                st4bf(P.Sg() + ((((size_t)(b * 64 + cidx) * 8 + h) * 8 + nt) * 4 + pt) * 256 + lane * 4, acc); }
        }
    }
    __syncthreads();
}

DI void head_norm_rope_store(f32x4 (&x)[12], const float* hg, const float* cosp, const float* sinp, float scale, bf16_t* dstrow, int fq) {
    float ss = 0.f;
#pragma unroll
    for (int nt = 0; nt < 12; ++nt) ss += x[nt][0] * x[nt][0] + x[nt][1] * x[nt][1] + x[nt][2] * x[nt][2] + x[nt][3] * x[nt][3];
    ss += __shfl_xor(ss, 16); ss += __shfl_xor(ss, 32);
    const float rs = rsqrtf(ss * (1.0f / 192.0f) + EPS_);
#pragma unroll
    for (int nt = 0; nt < 12; ++nt) { const f32x4 g = *(const f32x4*)(hg + nt * 16 + fq * 4); x[nt] = x[nt] * rs * g; }
#pragma unroll
    for (int nt = 8; nt < 10; ++nt) { const f32x4 c = *(const f32x4*)(cosp + (nt - 8) * 16 + fq * 4), s = *(const f32x4*)(sinp + (nt - 8) * 16 + fq * 4);
        const f32x4 x1 = x[nt], x2 = x[nt + 2]; x[nt] = x1 * c - x2 * s; x[nt + 2] = x2 * c + x1 * s; }
#pragma unroll
    for (int nt = 0; nt < 12; ++nt) st4bf(dstrow + nt * 16 + fq * 4, x[nt] * scale);
}

DI void p2_mla(const Params& P, int l, int b, int t0, unsigned char* sm) {
    bf16_t* cqL = (bf16_t*)sm; bf16_t* ckvL = (bf16_t*)(sm + 50176);
    const int tid = tidl(), wid = tid >> 6, lane = tid & 63, fr = lane & 15, fq = lane >> 4; const size_t tokb = (size_t)b * S_ + t0;
#pragma unroll
    for (int i = 0; i < 8; ++i) { const int tl = wid * 8 + i; const bf16_t* up = P.u() + (tokb + tl) * NINP;
        float xq[6], ss = 0.f;
#pragma unroll
        for (int k = 0; k < 6; ++k) { xq[k] = bf2f(up[U_CQ + lane + 64 * k]); ss += xq[k] * xq[k]; }
        ss = wsum(ss); const float rs = rsqrtf(ss * (1.0f / 384.0f) + EPS_);
#pragma unroll
        for (int k = 0; k < 6; ++k) cqL[tl * 392 + lane + 64 * k] = f2bf(xq[k] * rs);
        const float k0 = bf2f(up[U_CKV + lane]), k1 = bf2f(up[U_CKV + lane + 64]);
        const float s2 = wsum(k0 * k0 + k1 * k1), rs2 = rsqrtf(s2 * (1.0f / 128.0f) + EPS_);
        ckvL[tl * 136 + lane] = f2bf(k0 * rs2); ckvL[tl * 136 + lane + 64] = f2bf(k1 * rs2); }
    __syncthreads();
    const int h = wid >> 1, tp = wid & 1;
    const bf16_t* Wq = P.WuqT() + (size_t)l * 768 * 384 + (size_t)(h * 192) * 384;
    const bf16_t* Wkv = P.WukvT() + (size_t)l * 1024 * 128 + (size_t)(h * 256) * 128;
    {
        const int tl0 = (2 * tp) * 16 + fr, tl1 = tl0 + 16; const size_t tok0 = tokb + tl0, tok1 = tokb + tl1;
        {
            f32x4 x0[12], x1[12];
#pragma unroll
            for (int ng = 0; ng < 6; ++ng) { bf16x8 wa[2][12];
#pragma unroll
                for (int q2 = 0; q2 < 2; ++q2) { const bf16_t* wp = launder_p(Wq + (size_t)((2 * ng + q2) * 16 + fr) * 384 + fq * 8);
#pragma unroll
                    for (int ks = 0; ks < 12; ++ks) wa[q2][ks] = *(const bf16x8*)(wp + ks * 32); }
#pragma unroll
                for (int q2 = 0; q2 < 2; ++q2) { f32x4 a0 = fz4(), a1 = fz4();
#pragma unroll
                    for (int ks = 0; ks < 12; ++ks) { a0 = mfma16(wa[q2][ks], *(const bf16x8*)(cqL + tl0 * 392 + ks * 32 + fq * 8), a0); a1 = mfma16(wa[q2][ks], *(const bf16x8*)(cqL + tl1 * 392 + ks * 32 + fq * 8), a1); }
                    x0[2 * ng + q2] = a0; x1[2 * ng + q2] = a1; }
                __builtin_amdgcn_sched_barrier(0); }
            head_norm_rope_store(x0, P.qhg + l * 192, P.cosM() + tok0 * 32, P.sinM() + tok0 * 32, 0.07216878364870322f * LOG2E, P.Qc() + (tok0 * 4 + h) * 192, fq);
            head_norm_rope_store(x1, P.qhg + l * 192, P.cosM() + tok1 * 32, P.sinM() + tok1 * 32, 0.07216878364870322f * LOG2E, P.Qc() + (tok1 * 4 + h) * 192, fq);
        }
        bf16x8 bk0[4], bk1[4];
#pragma unroll
        for (int ks = 0; ks < 4; ++ks) { bk0[ks] = *(const bf16x8*)(ckvL + tl0 * 136 + ks * 32 + fq * 8); bk1[ks] = *(const bf16x8*)(ckvL + tl1 * 136 + ks * 32 + fq * 8); }
        {
            f32x4 x0[12], x1[12];
#pragma unroll
            for (int ng = 0; ng < 2; ++ng) { bf16x8 wa[4][4];
#pragma unroll
                for (int q4 = 0; q4 < 4; ++q4) { const bf16_t* wp = launder_p(Wkv + (size_t)((4 * ng + q4) * 16 + fr) * 128 + fq * 8);
#pragma unroll
                    for (int ks = 0; ks < 4; ++ks) wa[q4][ks] = *(const bf16x8*)(wp + ks * 32); }
#pragma unroll
                for (int q4 = 0; q4 < 4; ++q4) { f32x4 a0 = fz4(), a1 = fz4();
#pragma unroll
                    for (int ks = 0; ks < 4; ++ks) { a0 = mfma16(wa[q4][ks], bk0[ks], a0); a1 = mfma16(wa[q4][ks], bk1[ks], a1); }
                    x0[4 * ng + q4] = a0; x1[4 * ng + q4] = a1; }
                __builtin_amdgcn_sched_barrier(0); }
#pragma unroll
            for (int nt = 8; nt < 12; ++nt) { x0[nt] = ld4bf(P.u() + tok0 * NINP + U_CKR + (nt - 8) * 16 + fq * 4); x1[nt] = ld4bf(P.u() + tok1 * NINP + U_CKR + (nt - 8) * 16 + fq * 4); }
            head_norm_rope_store(x0, P.khg + l * 192, P.cosM() + tok0 * 32, P.sinM() + tok0 * 32, 1.0f, P.Kc() + (((size_t)(b * 4 + h)) * S_ + t0 + tl0) * 192, fq);
            head_norm_rope_store(x1, P.khg + l * 192, P.cosM() + tok1 * 32, P.sinM() + tok1 * 32, 1.0f, P.Kc() + (((size_t)(b * 4 + h)) * S_ + t0 + tl1) * 192, fq);
        }
        {
#pragma unroll
            for (int ng = 0; ng < 2; ++ng) { bf16x8 wa[4][4];
#pragma unroll
                for (int q4 = 0; q4 < 4; ++q4) { const bf16_t* wp = launder_p(Wkv + (size_t)(128 + (4 * ng + q4) * 16 + fr) * 128 + fq * 8);
#pragma unroll
                    for (int ks = 0; ks < 4; ++ks) wa[q4][ks] = *(const bf16x8*)(wp + ks * 32); }
#pragma unroll
                for (int q4 = 0; q4 < 4; ++q4) { f32x4 a0 = fz4(), a1 = fz4();
#pragma unroll
                    for (int ks = 0; ks < 4; ++ks) { a0 = mfma16(wa[q4][ks], bk0[ks], a0); a1 = mfma16(wa[q4][ks], bk1[ks], a1); }
#pragma unroll
                    for (int i = 0; i < 4; ++i) { bf16_t* vp = P.Vct() + ((size_t)b * 512 + h * 128 + (4 * ng + q4) * 16 + fq * 4 + i) * S_ + t0; vp[tl0] = f2bf(a0[i]); vp[tl1] = f2bf(a1[i]); } }
                __builtin_amdgcn_sched_barrier(0); }
        }
    }
    __syncthreads();
}

DI void p2_dil(const Params& P, int l, int b, int t0, unsigned char* sm) {
    bf16_t* vL = (bf16_t*)sm;
    const int tid = tidl(), wid = tid >> 6, lane = tid & 63; const size_t tokb = (size_t)b * S_ + t0;
    u32x4 vpre[8];
#pragma unroll
    for (int i = 0; i < 8; ++i) { const int e = tid + 512 * i, tl = e >> 6, c8 = (e & 63) * 8; vpre[i] = *(const u32x4*)(P.u() + (tokb + tl) * NINP + U_DV + c8); }
    {
        const int c = lane & 15, sub = lane >> 4;
        const f32x4 gq1 = *(const f32x4*)(P.dqg + l * 128 + 4 * c), gq2 = *(const f32x4*)(P.dqg + l * 128 + 64 + 4 * c), gk1 = *(const f32x4*)(P.dkg + l * 128 + 4 * c), gk2 = *(const f32x4*)(P.dkg + l * 128 + 64 + 4 * c);
#pragma unroll 1
        for (int rb = 0; rb < 16; rb += 4) { u32x2 r1[4], r2[4]; f32x4 cs[4], sn[4];
#pragma unroll
            for (int q = 0; q < 4; ++q) { const int row = wid * 64 + (rb + q) * 4 + sub, qk = row & 1, h = (row >> 1) & 3, tl = row >> 3; const size_t tok = tokb + tl;
                const bf16_t* up = P.u() + tok * NINP + (qk ? U_DK : U_DQ) + h * 128; r1[q] = *(const u32x2*)(up + 4 * c); r2[q] = *(const u32x2*)(up + 64 + 4 * c);
                cs[q] = *(const f32x4*)(P.cosD() + tok * 64 + 4 * c); sn[q] = *(const f32x4*)(P.sinD() + tok * 64 + 4 * c); }
#pragma unroll
            for (int q = 0; q < 4; ++q) { const int row = wid * 64 + (rb + q) * 4 + sub, qk = row & 1, h = (row >> 1) & 3, tl = row >> 3; const size_t tok = tokb + tl;
                f32x4 x1, x2; x1[0] = lo2f(r1[q].x); x1[1] = hi2f(r1[q].x); x1[2] = lo2f(r1[q].y); x1[3] = hi2f(r1[q].y); x2[0] = lo2f(r2[q].x); x2[1] = hi2f(r2[q].x); x2[2] = lo2f(r2[q].y); x2[3] = hi2f(r2[q].y);
                float ss = (x1[0] * x1[0] + x1[1] * x1[1]) + (x1[2] * x1[2] + x1[3] * x1[3]) + (x2[0] * x2[0] + x2[1] * x2[1]) + (x2[2] * x2[2] + x2[3] * x2[3]);
                ss += __shfl_xor(ss, 1); ss += __shfl_xor(ss, 2); ss += __shfl_xor(ss, 4); ss += __shfl_xor(ss, 8);
                const float rs = rsqrtf(ss * (1.0f / 128.0f) + EPS_);
                const f32x4 y1 = x1 * rs * (qk ? gk1 : gq1), y2 = x2 * rs * (qk ? gk2 : gq2); const float sc = qk ? 1.0f : 0.08838834764831845f * LOG2E;
                bf16_t* dp = (qk ? P.dk() : P.dq()) + tok * 512 + h * 128; st4bf(dp + 4 * c, (y1 * cs[q] - y2 * sn[q]) * sc); st4bf(dp + 64 + 4 * c, (y2 * cs[q] + y1 * sn[q]) * sc); } }
    }
#pragma unroll
    for (int i = 0; i < 8; ++i) { const int e = tid + 512 * i, tl = e >> 6, c8 = (e & 63) * 8; *(u32x4*)(vL + tl * 520 + c8) = vpre[i]; }
    __syncthreads();
    tr_out(vL, 520, 9, P.Vt1() + (size_t)b * 512 * S_, t0, 1);
    tr_out(vL, 520, 9, P.Vt4() + (size_t)b * 512 * S_, t0, 4);
    tr_out(vL, 520, 9, P.Vt16() + (size_t)b * 512 * S_, t0, 16);
    __syncthreads();
}

DI void phase2(const Params& P, int l, unsigned char* sm) {
    for (int it = blockIdx.x; it < 256; it += gridDim.x) { const int b = it >> 6, t0 = (it & 63) * 64;
#ifdef PROBE_P2
#define P2SPIN(k, call) do { const unsigned long long q0_ = wall_clock64(); call; if (PROBE_P2 == k) { const unsigned long long q1_ = wall_clock64(); while (wall_clock64() - q1_ < q1_ - q0_) __builtin_amdgcn_s_sleep(8); } } while (0)
#else
#define P2SPIN(k, call) call
#endif
        P2SPIN(1, p2_gla(P, l, b, t0, sm)); P2SPIN(2, p2_ssd(P, l, b, t0, sm)); P2SPIN(3, p2_mla(P, l, b, t0, sm)); P2SPIN(4, p2_dil(P, l, b, t0, sm)); }
}

DI void p3_gla_scan(const Params& P, int j) {
    const int tid = tidl(), wid = tid >> 6, lane = tid & 63, fq = lane >> 4; const int bh = j >> 2, b = bh >> 2, h = bh & 3, tix = (j & 3) * 8 + wid, kt = tix >> 3, dvt = tix & 7;
    f32x4 S = fz4();
#pragma unroll 1
    for (int tb = 0; tb < 64; tb += 8) {
        u32x2 lv[8]; f32x4 D[8];
#pragma unroll
        for (int q = 0; q < 8; ++q) { const int t = tb + q; const size_t off = (((((size_t)(b * 64 + t) * 4 + h) * 4 + kt) * 8 + dvt) * 256) + lane * 4;
            lv[q] = *(const u32x2*)(P.Lg() + off);
            D[q] = *(const f32x4*)(P.Dt() + ((size_t)b * 64 + t) * 256 + h * 64 + 16 * kt + 4 * fq); }
#pragma unroll
        for (int q = 0; q < 8; ++q) { const int t = tb + q; const size_t off = (((((size_t)(b * 64 + t) * 4 + h) * 4 + kt) * 8 + dvt) * 256) + lane * 4;
            f32x4 Lv; Lv[0] = lo2f(lv[q].x); Lv[1] = hi2f(lv[q].x); Lv[2] = lo2f(lv[q].y); Lv[3] = hi2f(lv[q].y);
            st4bf(P.Sst() + off, S); S = S * D[q] + Lv; }
    }
}
DI void p3b_gla(const Params& P, int l, int b, int tile, int h, float* oL) {
    const int tid = tidl(), w = tid >> 6, lane = tid & 63, fr = lane & 15, fq = lane >> 4, dv0 = w * 16;
    f32x4 Sa[4];
#pragma unroll
    for (int kt = 0; kt < 4; ++kt) Sa[kt] = ld4bf(P.Sst() + (((((size_t)(b * 64 + tile) * 4 + h) * 4 + kt) * 8 + w) * 256) + lane * 4);
    const bf16_t* Qe = P.Qe() + (size_t)b * S_ * 256 + h * 64;
    const bf16_t* KdT = P.KdT() + ((size_t)b * 256 + h * 64) * S_;
    const bf16_t* vT = P.gvT() + ((size_t)b * 512 + h * 128 + dv0 + fr) * S_;
    const float* dec = P.dec() + (size_t)b * 256 * 256 + h * 64;
    const bf16_t* og = P.ogla() + (size_t)b * S_ * 512 + h * 128 + dv0 + fr;
    bf16x8 qa[4][2], ka[3][4], vb[3]; f32x4 dc[3][4], oi[4];
#pragma unroll
    for (int ch = 0; ch < 4; ++ch) { const int n = tile * 4 + ch, tok0 = 16 * n;
#pragma unroll
        for (int s = 0; s < 2; ++s) qa[ch][s] = ldperm(Qe + (size_t)(tok0 + fr) * 256 + 32 * s, fq);
#pragma unroll
        for (int i = 0; i < 4; ++i) oi[ch][i] = bf2f(og[(size_t)(tok0 + 4 * fq + i) * 512]);
        if (ch < 3) {
#pragma unroll
            for (int kt = 0; kt < 4; ++kt) { ka[ch][kt] = zero8(); if (fq < 2) ka[ch][kt] = *(const bf16x8*)(KdT + (size_t)(16 * kt + fr) * S_ + tok0 + 8 * fq); dc[ch][kt] = *(const f32x4*)(dec + (size_t)n * 256 + 16 * kt + 4 * fq); }
            vb[ch] = zero8(); if (fq < 2) vb[ch] = *(const bf16x8*)(vT + tok0 + 8 * fq); } }
#pragma unroll
    for (int ch = 0; ch < 4; ++ch) {
        f32x4 o = fz4();
#pragma unroll
        for (int s = 0; s < 2; ++s) o = mfma16(qa[ch][s], pack8(Sa[2 * s], Sa[2 * s + 1]), o);
#pragma unroll
        for (int i = 0; i < 4; ++i) oL[(ch * 16 + 4 * fq + i) * 132 + dv0 + fr] = o[i] + oi[ch][i];
        if (ch < 3) {
#pragma unroll
            for (int kt = 0; kt < 4; ++kt) { Sa[kt] = Sa[kt] * dc[ch][kt]; Sa[kt] = mfma16(ka[ch][kt], vb[ch], Sa[kt]); } }
    }
    __syncthreads();
    const size_t tokb = (size_t)b * S_ + tile * 64;
    {
        const int c = lane & 15, sub = lane >> 4;
        const f32x4 g0 = *(const f32x4*)(P.gng + l * 128 + 8 * c), g1 = *(const f32x4*)(P.gng + l * 128 + 8 * c + 4);
        u32x4 gvs[2];
#pragma unroll
        for (int i = 0; i < 2; ++i) gvs[i] = *(const u32x4*)(P.u() + (tokb + w * 8 + i * 4 + sub) * NINP + U_GA + h * 128 + 8 * c);
#pragma unroll
        for (int i = 0; i < 2; ++i) { const int tl = w * 8 + i * 4 + sub;
            const f32x4 x0 = *(const f32x4*)(oL + tl * 132 + 8 * c), x1 = *(const f32x4*)(oL + tl * 132 + 8 * c + 4);
            float ss = (x0[0] * x0[0] + x0[1] * x0[1]) + (x0[2] * x0[2] + x0[3] * x0[3]) + (x1[0] * x1[0] + x1[1] * x1[1]) + (x1[2] * x1[2] + x1[3] * x1[3]);
            ss += __shfl_xor(ss, 1); ss += __shfl_xor(ss, 2); ss += __shfl_xor(ss, 4); ss += __shfl_xor(ss, 8);
            const float rs = rsqrtf(ss * (1.0f / 128.0f) + EPS_);
            const u32x4 gv = gvs[i];
            u32x4 o;
            o.x = pk2(x0[0] * rs * g0[0] * silu_f(lo2f(gv.x)), x0[1] * rs * g0[1] * silu_f(hi2f(gv.x)));
            o.y = pk2(x0[2] * rs * g0[2] * silu_f(lo2f(gv.y)), x0[3] * rs * g0[3] * silu_f(hi2f(gv.y)));
            o.z = pk2(x1[0] * rs * g1[0] * silu_f(lo2f(gv.z)), x1[1] * rs * g1[1] * silu_f(hi2f(gv.z)));
            o.w = pk2(x1[2] * rs * g1[2] * silu_f(lo2f(gv.w)), x1[3] * rs * g1[3] * silu_f(hi2f(gv.w)));
            *(u32x4*)(P.y() + (tokb + tl) * 2048 + h * 128 + 8 * c) = o; }
    }
    __syncthreads();
}
DI void p3_ssd_scan(const Params& P, int j) {
    const int tid = tidl(), wid = tid >> 6, lane = tid & 63; const int bh = j >> 2, b = bh >> 3, h = bh & 7, tix = (j & 3) * 8 + wid;
    f32x4 prev = fz4();
#pragma unroll 1
    for (int cb = 0; cb < 64; cb += 16) {
        u32x2 sv[16]; float al[16];
#pragma unroll
        for (int q = 0; q < 16; ++q) { const size_t bc = (size_t)b * 64 + cb + q; sv[q] = *(const u32x2*)(P.Sg() + ((bc * 8 + h) * 32 + tix) * 256 + lane * 4); al[q] = P.Acs()[(bc * 8 + h) * 64 + 63]; }
#pragma unroll
        for (int q = 0; q < 16; ++q) { const size_t bc = (size_t)b * 64 + cb + q; const size_t off = ((bc * 8 + h) * 32 + tix) * 256 + lane * 4;
            f32x4 s4; s4[0] = lo2f(sv[q].x); s4[1] = hi2f(sv[q].x); s4[2] = lo2f(sv[q].y); s4[3] = hi2f(sv[q].y);
            st4bf(P.Pv() + off, prev); prev = prev * __expf(al[q]) + s4; }
    }
}
DI void ssd_chunk2(const Params& P, int l, int b, int c, int h, int ps0, f32x4 (&yacc)[2][4]) {
    const int lane = tidl() & 63, fr = lane & 15, fq = lane >> 4, g = h >> 2;
    const float Dh = P.sD[l * 8 + h];
    const bf16_t* Bm = P.Bm() + (size_t)b * S_ * 256 + g * 128; const bf16_t* Cm = P.Cm() + (size_t)b * S_ * 256 + g * 128;
    const bf16_t* XdtT = P.XdtT() + ((size_t)b * 512 + h * 64 + ps0 * 16 + fr) * S_;
    const bf16_t* xs = P.xs() + (size_t)b * S_ * 512 + h * 64 + ps0 * 16;
    const int tok0 = 64 * c; const float* acs = P.Acs() + (((size_t)b * 64 + c) * 8 + h) * 64;
    const bf16_t* pv = P.Pv() + (((size_t)(b * 64 + c) * 8 + h) * 32) * 256 + lane * 4;
    float acl[4]; f32x4 acsS[4];
#pragma unroll
    for (int t = 0; t < 4; ++t) { acl[t] = acs[16 * t + fr]; acsS[t] = *(const f32x4*)(acs + 16 * t + 4 * fq); }
    bf16x8 Cp[4][4];
#pragma unroll
    for (int lt = 0; lt < 4; ++lt)
#pragma unroll
        for (int ks = 0; ks < 4; ++ks) Cp[lt][ks] = ldperm(Cm + (size_t)(tok0 + 16 * lt + fr) * 256 + 32 * ks, fq);
    bf16x8 pa[2][4];
#pragma unroll
    for (int p = 0; p < 2; ++p)
#pragma unroll
        for (int ks = 0; ks < 4; ++ks) pa[p][ks] = cat4(*(const s16x4*)(pv + ((2 * ks) * 4 + ps0 + p) * 256), *(const s16x4*)(pv + ((2 * ks + 1) * 4 + ps0 + p) * 256));
    f32x4 xv[2][4];
#pragma unroll
    for (int p = 0; p < 2; ++p)
#pragma unroll
        for (int lt = 0; lt < 4; ++lt) xv[p][lt] = ld4bf(xs + (size_t)(tok0 + 16 * lt + fr) * 512 + 16 * p + 4 * fq);
#pragma unroll
    for (int lt = 0; lt < 4; ++lt) { const float el = __expf(acl[lt]);
#pragma unroll
        for (int p = 0; p < 2; ++p) { f32x4 yo = fz4();
#pragma unroll
            for (int ks = 0; ks < 4; ++ks) yo = mfma16(pa[p][ks], Cp[lt][ks], yo);
            yacc[p][lt] = yo * el + xv[p][lt] * Dh; } }
#pragma unroll
    for (int ks2 = 0; ks2 < 2; ++ks2) {
        bf16x8 Bp0[4], Bp1[4];
#pragma unroll
        for (int ks = 0; ks < 4; ++ks) { Bp0[ks] = ldperm(Bm + (size_t)(tok0 + 32 * ks2 + fr) * 256 + 32 * ks, fq); Bp1[ks] = ldperm(Bm + (size_t)(tok0 + 32 * ks2 + 16 + fr) * 256 + 32 * ks, fq); }
        const bf16x8 xa0 = ldperm(XdtT + tok0 + 32 * ks2, fq), xa1 = ldperm(XdtT + (size_t)16 * S_ + tok0 + 32 * ks2, fq);
#pragma unroll
        for (int lt = 2 * ks2; lt < 4; ++lt) {
            f32x4 g0 = fz4(), g1 = fz4();
#pragma unroll
            for (int ks = 0; ks < 4; ++ks) { g0 = mfma16(Bp0[ks], Cp[lt][ks], g0); g1 = mfma16(Bp1[ks], Cp[lt][ks], g1); }
            const int lpos = 16 * lt + fr;
#pragma unroll
            for (int i = 0; i < 4; ++i) { const int s0 = 32 * ks2 + 4 * fq + i, s1 = s0 + 16;
                const float e0 = __expf(acl[lt] - acsS[2 * ks2][i]), e1 = __expf(acl[lt] - acsS[2 * ks2 + 1][i]);
                g0[i] = (s0 <= lpos) ? g0[i] * e0 : 0.f; g1[i] = (s1 <= lpos) ? g1[i] * e1 : 0.f; }
            const bf16x8 pk = pack8(g0, g1);
            yacc[0][lt] = mfma16(xa0, pk, yacc[0][lt]); yacc[1][lt] = mfma16(xa1, pk, yacc[1][lt]);
        }
    }
}

DI void ssd_chunk3(const Params& P, int l, int b, int c, int h, int ps0, const bf16_t* CL, const float* GT, f32x4 (&yacc)[2][4]) {
    const int lane = tidl() & 63, fr = lane & 15, fq = lane >> 4;
    const float Dh = P.sD[l * 8 + h];
    const bf16_t* XdtT = P.XdtT() + ((size_t)b * 512 + h * 64 + ps0 * 16 + fr) * S_;
    const bf16_t* xs = P.xs() + (size_t)b * S_ * 512 + h * 64 + ps0 * 16;
    const int tok0 = 64 * c; const float* acs = P.Acs() + (((size_t)b * 64 + c) * 8 + h) * 64;
    const bf16_t* pv = P.Pv() + (((size_t)(b * 64 + c) * 8 + h) * 32) * 256 + lane * 4;
    float acl[4]; f32x4 acsS[4];
#pragma unroll
    for (int t = 0; t < 4; ++t) { acl[t] = acs[16 * t + fr]; acsS[t] = *(const f32x4*)(acs + 16 * t + 4 * fq); }
    bf16x8 pa[2][4];
#pragma unroll
    for (int p = 0; p < 2; ++p)
#pragma unroll
        for (int ks = 0; ks < 4; ++ks) pa[p][ks] = cat4(*(const s16x4*)(pv + ((2 * ks) * 4 + ps0 + p) * 256), *(const s16x4*)(pv + ((2 * ks + 1) * 4 + ps0 + p) * 256));
    f32x4 xv[2][4];
#pragma unroll
    for (int p = 0; p < 2; ++p)
#pragma unroll
        for (int lt = 0; lt < 4; ++lt) xv[p][lt] = ld4bf(xs + (size_t)(tok0 + 16 * lt + fr) * 512 + 16 * p + 4 * fq);
    bf16x8 xa[2][2];
#pragma unroll
    for (int ks2 = 0; ks2 < 2; ++ks2) { xa[0][ks2] = ldperm(XdtT + tok0 + 32 * ks2, fq); xa[1][ks2] = ldperm(XdtT + (size_t)16 * S_ + tok0 + 32 * ks2, fq); }
#pragma unroll
    for (int lt = 0; lt < 4; ++lt) { const float el = __expf(acl[lt]); f32x4 yo0 = fz4(), yo1 = fz4();
#pragma unroll
        for (int ks = 0; ks < 4; ++ks) { const bf16x8 cp = ldperm(CL + (16 * lt + fr) * 136 + 32 * ks, fq); yo0 = mfma16(pa[0][ks], cp, yo0); yo1 = mfma16(pa[1][ks], cp, yo1); }
        yacc[0][lt] = yo0 * el + xv[0][lt] * Dh; yacc[1][lt] = yo1 * el + xv[1][lt] * Dh; }
#pragma unroll
    for (int ks2 = 0; ks2 < 2; ++ks2)
#pragma unroll
        for (int lt = 2 * ks2; lt < 4; ++lt) {
            f32x4 g0 = *(const f32x4*)(GT + ((2 * ks2) * 4 + lt) * 256 + lane * 4), g1 = (2 * ks2 + 1 <= lt) ? *(const f32x4*)(GT + ((2 * ks2 + 1) * 4 + lt) * 256 + lane * 4) : fz4();
            const int lpos = 16 * lt + fr;
#pragma unroll
            for (int i = 0; i < 4; ++i) { const int s0 = 32 * ks2 + 4 * fq + i, s1 = s0 + 16;
                const float e0 = __expf(acl[lt] - acsS[2 * ks2][i]), e1 = __expf(acl[lt] - acsS[2 * ks2 + 1][i]);
                g0[i] = (s0 <= lpos) ? g0[i] * e0 : 0.f; g1[i] = (s1 <= lpos) ? g1[i] * e1 : 0.f; }
            const bf16x8 pk = pack8(g0, g1);
            yacc[0][lt] = mfma16(xa[0][ks2], pk, yacc[0][lt]); yacc[1][lt] = mfma16(xa[1][ks2], pk, yacc[1][lt]);
        }
}

DI void p3_mla(const Params& P, int b, int h, int qb, unsigned char* sm) {
    bf16_t* KL = (bf16_t*)sm; bf16_t* VL = (bf16_t*)(sm + 25600);
    const int tid = tidl(), wid = tid >> 6, lane = tid & 63, fr = lane & 15, fq = lane >> 4;
    const int qbase = qb * 256 + wid * 32;
    bf16x8 Qf[2][6];
#pragma unroll
    for (int qt = 0; qt < 2; ++qt)
#pragma unroll
        for (int ks = 0; ks < 6; ++ks) Qf[qt][ks] = *(const bf16x8*)(P.Qc() + (((size_t)b * S_ + qbase + qt * 16 + fr) * 4 + h) * 192 + ks * 32 + fq * 8);
    f32x4 oacc[2][8];
#pragma unroll
    for (int i = 0; i < 8; ++i) { oacc[0][i] = fz4(); oacc[1][i] = fz4(); }
    float m[2] = {-1e30f, -1e30f}, lsum[2] = {0.f, 0.f};
    const bf16_t* Kg = P.Kc() + ((size_t)(b * 4 + h)) * S_ * 192; const bf16_t* Vg = P.Vct() + ((size_t)b * 512 + h * 128) * S_;
    const int nkt = 4 * qb + 4;
    u32x4 kr[3], vr[2];
#define MLA_GLOAD(kt) do { _Pragma("unroll") for (int i = 0; i < 3; ++i) { const int e = tid + 512 * i, row = e / 24, c16 = e % 24; kr[i] = *(const u32x4*)(Kg + (size_t)((kt) * 64 + row) * 192 + c16 * 8); } \
                           _Pragma("unroll") for (int i = 0; i < 2; ++i) { const int e = tid + 512 * i, row = e >> 3, c16 = e & 7; vr[i] = *(const u32x4*)(Vg + (size_t)row * S_ + (kt) * 64 + c16 * 8); } } while (0)
    MLA_GLOAD(0);
#pragma unroll 1
    for (int kt = 0; kt < nkt; ++kt) {
        __syncthreads();
#pragma unroll
        for (int i = 0; i < 3; ++i) { const int e = tid + 512 * i, row = e / 24, c16 = e % 24; *(u32x4*)(KL + row * 200 + c16 * 8) = kr[i]; }
#pragma unroll
        for (int i = 0; i < 2; ++i) { const int e = tid + 512 * i, row = e >> 3, c16 = e & 7; *(u32x4*)(VL + row * 72 + c16 * 8) = vr[i]; }
        __syncthreads();
        if (kt + 1 < nkt) MLA_GLOAD(kt + 1);
        if (kt * 64 <= qbase + 31) {
            f32x4 s[2][4]; bf16x8 ka[2][6];
#pragma unroll
            for (int j = 0; j < 4; ++j) { s[0][j] = fz4(); s[1][j] = fz4();
                if (j == 0) {
#pragma unroll
                    for (int ks = 0; ks < 6; ++ks) ka[0][ks] = *(const bf16x8*)(KL + fr * 200 + ks * 32 + fq * 8); }
                if (j < 3) {
#pragma unroll
                    for (int ks = 0; ks < 6; ++ks) ka[(j + 1) & 1][ks] = *(const bf16x8*)(KL + ((j + 1) * 16 + fr) * 200 + ks * 32 + fq * 8); }
                __builtin_amdgcn_sched_barrier(0);
#pragma unroll
                for (int ks = 0; ks < 6; ++ks) { const bf16x8 a = ka[j & 1][ks]; s[0][j] = mfma16(a, Qf[0][ks], s[0][j]); s[1][j] = mfma16(a, Qf[1][ks], s[1][j]); }
                __builtin_amdgcn_sched_barrier(0); }
            bf16x8 pb[2][2];
#pragma unroll
            for (int qt = 0; qt < 2; ++qt) { const int qrow = qbase + qt * 16 + fr;
                if (kt >= 4 * qb) {
#pragma unroll
                    for (int j = 0; j < 4; ++j)
#pragma unroll
                        for (int i = 0; i < 4; ++i) { const int key = kt * 64 + j * 16 + fq * 4 + i; if (key > qrow) s[qt][j][i] = -1e30f; } }
                float mx = -1e30f;
#pragma unroll
                for (int j = 0; j < 4; ++j) mx = fmaxf(mx, fmaxf(fmaxf(s[qt][j][0], s[qt][j][1]), fmaxf(s[qt][j][2], s[qt][j][3])));
                mx = fmaxf(mx, __shfl_xor(mx, 16)); mx = fmaxf(mx, __shfl_xor(mx, 32));
                const float mn = fmaxf(m[qt], mx), alpha = __builtin_amdgcn_exp2f(m[qt] - mn); m[qt] = mn;
                float psum = 0.f;
#pragma unroll
                for (int j = 0; j < 4; ++j)
#pragma unroll
                    for (int i = 0; i < 4; ++i) { s[qt][j][i] = __builtin_amdgcn_exp2f(s[qt][j][i] - mn); psum += s[qt][j][i]; }
                lsum[qt] = lsum[qt] * alpha + psum;
                if (__builtin_amdgcn_ballot_w64(alpha != 1.0f) != 0ull) {
#pragma unroll
                    for (int dt = 0; dt < 8; ++dt) oacc[qt][dt] = oacc[qt][dt] * alpha; }
                pb[qt][0] = pack8(s[qt][0], s[qt][1]); pb[qt][1] = pack8(s[qt][2], s[qt][3]); }
#pragma unroll
            for (int kk = 0; kk < 2; ++kk) { bf16x8 va[8];
#pragma unroll
                for (int dt = 0; dt < 8; ++dt) va[dt] = ldperm(VL + (dt * 16 + fr) * 72 + kk * 32, fq);
                __builtin_amdgcn_sched_barrier(0);
#pragma unroll
                for (int dt = 0; dt < 8; ++dt) { const bf16x8 a = va[dt]; oacc[0][dt] = mfma16(a, pb[0][kk], oacc[0][dt]); oacc[1][dt] = mfma16(a, pb[1][kk], oacc[1][dt]); } }
        }
    }
#undef MLA_GLOAD
#pragma unroll
    for (int qt = 0; qt < 2; ++qt) { float ls = lsum[qt]; ls += __shfl_xor(ls, 16); ls += __shfl_xor(ls, 32); const float inv = 1.0f / ls;
        const size_t tokq = (size_t)b * S_ + qbase + qt * 16 + fr;
        f32x4 gvv[8];
#pragma unroll
        for (int dt = 0; dt < 8; ++dt) gvv[dt] = ld4bf(P.u() + tokq * NINP + U_GC + h * 128 + dt * 16 + fq * 4);
#pragma unroll
        for (int dt = 0; dt < 8; ++dt) { const f32x4 gv = gvv[dt]; f32x4 o = oacc[qt][dt] * inv;
            o[0] *= silu_f(gv[0]); o[1] *= silu_f(gv[1]); o[2] *= silu_f(gv[2]); o[3] *= silu_f(gv[3]);
            st4bf(P.y() + tokq * 2048 + 1024 + h * 128 + dt * 16 + fq * 4, o); } }
}

struct DilItem { int cfg, b, h, d, Pn, rd, P0; };
DI DilItem dil_decode(int j) { DilItem t; t.cfg = j >> 9; const int jj = j & 511, bh = jj >> 5, q = jj & 31; t.b = bh >> 2; t.h = bh & 3;
    t.d = t.cfg == 0 ? 1 : (t.cfg == 1 ? 4 : 16); t.Pn = S_ / t.d;
    t.rd = t.cfg == 0 ? 0 : (t.cfg == 1 ? (q >> 3) : (q >> 1)); t.P0 = (t.cfg == 0 ? q : (t.cfg == 1 ? (q & 7) : (q & 1))) * 128; return t; }
DI void p3_dil2(const Params& P, int l, int j, unsigned char* sm, int* s_item) {
    bf16_t* KL = (bf16_t*)sm; bf16_t* VL = (bf16_t*)sm;
    const int tid = tidl(), w = tid >> 6, lane = tid & 63, fr = lane & 15, fq = lane >> 4;
    const float mgq = wmaxf(fmaxf(fabsf(P.dqg[l * 128 + lane]), fabsf(P.dqg[l * 128 + 64 + lane]))), mgk = wmaxf(fmaxf(fabsf(P.dkg[l * 128 + lane]), fabsf(P.dkg[l * 128 + 64 + lane])));
    const float Mb = 11.313708498984761f * LOG2E * mgq * mgk;
    u32x4 rg[8], rv[8];
#define DIL_KLOAD(T) do { const bf16_t* dkb_ = P.dk() + (size_t)(T).b * S_ * 512 + (T).h * 128; \
        _Pragma("unroll") for (int i = 0; i < 8; ++i) { const int u = tid + 512 * i, row = u >> 4, c16 = u & 15, kp = (T).P0 - 128 + row; \
            rg[i] = (u32x4){0u, 0u, 0u, 0u}; if (kp >= 0) rg[i] = *(const u32x4*)(dkb_ + (size_t)(kp * (T).d + (T).rd) * 512 + c16 * 8); } } while (0)
    DilItem t = dil_decode(j);
    DIL_KLOAD(t);
    for (;;) {
        const bf16_t* vtb = (t.cfg == 0 ? P.Vt1() : (t.cfg == 1 ? P.Vt4() : P.Vt16())) + ((size_t)t.b * 512 + t.h * 128) * S_; const int run = 64 / t.d, rlog = t.cfg == 0 ? 6 : (t.cfg == 1 ? 4 : 2);
        const int pq = t.P0 + 16 * w + fr; const size_t tokq = (size_t)t.b * S_ + pq * t.d + t.rd;
        bf16x8 Qf[4];
#pragma unroll
        for (int ks = 0; ks < 4; ++ks) Qf[ks] = *(const bf16x8*)(P.dq() + tokq * 512 + t.h * 128 + 32 * ks + 8 * fq);
#pragma unroll
        for (int i = 0; i < 8; ++i) { const int u = tid + 512 * i, row = u >> 4, c16 = u & 15; *(u32x4*)(KL + row * 136 + c16 * 8) = rg[i]; }
        __syncthreads();
        if (tid == 0) *s_item = (int)atomicAdd(P.ctr() + l, 1u);
#pragma unroll
        for (int i = 0; i < 8; ++i) { const int u = tid + 512 * i, row = u >> 5, c16 = u & 31, kp = t.P0 - 128 + c16 * 8;
            rv[i] = (u32x4){0u, 0u, 0u, 0u};
            if (kp >= 0) { const int k1 = kp + 4;
                const u32x2 lo = *(const u32x2*)(vtb + (size_t)row * S_ + ((kp >> rlog) << 6) + t.rd * run + (kp & (run - 1))), hi = *(const u32x2*)(vtb + (size_t)row * S_ + ((k1 >> rlog) << 6) + t.rd * run + (k1 & (run - 1)));
                rv[i] = (u32x4){lo.x, lo.y, hi.x, hi.y}; } }
        bf16x8 pb[5]; float lsum = 0.f;
#pragma unroll
        for (int kk = 0; kk < 5; ++kk) { f32x4 s0 = fz4(), s1 = fz4();
            const int r0 = min(16 * w + 32 * kk + fr, 255), r1 = min(16 * w + 32 * kk + 16 + fr, 255);
            bf16x8 ka0[4], ka1[4];
#pragma unroll
            for (int ks = 0; ks < 4; ++ks) { ka0[ks] = *(const bf16x8*)(KL + r0 * 136 + 32 * ks + 8 * fq); ka1[ks] = *(const bf16x8*)(KL + r1 * 136 + 32 * ks + 8 * fq); }
            __builtin_amdgcn_sched_barrier(0);
#pragma unroll
            for (int ks = 0; ks < 4; ++ks) { s0 = mfma16(ka0[ks], Qf[ks], s0); s1 = mfma16(ka1[ks], Qf[ks], s1); }
#pragma unroll
            for (int i = 0; i < 4; ++i) { const int rk = 16 * w + 32 * kk + 4 * fq + i, df = 128 + fr - 32 * kk - 4 * fq - i;
                const bool v0 = (df >= 0) && (df <= 128) && (t.P0 - 128 + rk >= 0), v1 = (df - 16 >= 0) && (df - 16 <= 128) && (t.P0 - 128 + rk + 16 >= 0);
                s0[i] = v0 ? __builtin_amdgcn_exp2f(s0[i] - Mb) : 0.f; s1[i] = v1 ? __builtin_amdgcn_exp2f(s1[i] - Mb) : 0.f; lsum += s0[i] + s1[i]; }
            pb[kk] = pack8(s0, s1); }
        __syncthreads();
        const int jn = *s_item - 448; const bool more = jn < 1536;
#pragma unroll
        for (int i = 0; i < 8; ++i) { const int u = tid + 512 * i, row = u >> 5, c16 = u & 31; *(u32x4*)(VL + row * 264 + c16 * 8) = rv[i]; }
        __syncthreads();
        DilItem tn = dil_decode(more ? jn : 0);
        if (more) DIL_KLOAD(tn);
        f32x4 oacc[8];
#pragma unroll
        for (int i = 0; i < 8; ++i) oacc[i] = fz4();
#pragma unroll
        for (int kk = 0; kk < 5; ++kk) { const int c0 = min(16 * w + 32 * kk + 4 * fq, 252), c1 = min(16 * w + 32 * kk + 16 + 4 * fq, 252);
            bf16x8 va[8];
#pragma unroll
            for (int dt = 0; dt < 8; ++dt) va[dt] = cat4(*(const s16x4*)(VL + (16 * dt + fr) * 264 + c0), *(const s16x4*)(VL + (16 * dt + fr) * 264 + c1));
            __builtin_amdgcn_sched_barrier(0);
#pragma unroll
            for (int dt = 0; dt < 8; ++dt) oacc[dt] = mfma16(va[dt], pb[kk], oacc[dt]); }
        lsum += __shfl_xor(lsum, 16); lsum += __shfl_xor(lsum, 32);
        bf16_t* op = t.cfg == 0 ? P.y() + tokq * 2048 + 1536 + t.h * 128 : (t.cfg == 1 ? P.Od4() : P.Od16()) + tokq * 512 + t.h * 128;
#pragma unroll
        for (int dt = 0; dt < 8; ++dt) st4bf(op + 16 * dt + 4 * fq, oacc[dt]);
        if (fq == 0) P.ldp()[((size_t)t.cfg * T_ + tokq) * 4 + t.h] = lsum;
        __syncthreads();
        if (!more) break;
        t = tn;
    }
#undef DIL_KLOAD
}

DI void phase3(const Params& P, int l, unsigned char* sm, int* s_item) {
    const int tid = tidl(), wid = tid >> 6;
#ifndef P3_DYNAMIC
#define P3_DYNAMIC 1
#endif
    for (int it_ = blockIdx.x;; it_ += gridDim.x) {
        __syncthreads();
#if P3_DYNAMIC
        if (tid == 0) *s_item = (int)atomicAdd(P.ctr() + l, 1u);
        __syncthreads();
        const int idx = *s_item;
#else
        const int idx = it_;
#endif
        if (idx >= P3_NITEMS) break;
#ifndef ONLY_P3
#define ONLY_P3 -1
#endif
#ifdef PROBE_ITEM
        const unsigned long long it0 = wall_clock64();
#endif
        if (idx < 256) { const int bh = idx & 15; if (ONLY_P3 < 0 || ONLY_P3 == 3) p3_mla(P, bh >> 2, bh & 3, 15 - (idx >> 4), sm); }
        else if (idx < 320) { if (ONLY_P3 < 0 || ONLY_P3 == 1) p3_gla_scan(P, idx - 256); }
        else if (idx < 448) { if (ONLY_P3 < 0 || ONLY_P3 == 2) p3_ssd_scan(P, idx - 320); }
        else { if (ONLY_P3 < 0 || ONLY_P3 == 4) p3_dil2(P, l, idx - 448, sm, s_item); }
#ifdef PROBE_ITEM
        { const int cls = idx < 256 ? 3 : (idx < 320 ? 1 : (idx < 448 ? 2 : 4)); if (cls == PROBE_ITEM) { const unsigned long long it1 = wall_clock64(); while (wall_clock64() - it1 < it1 - it0) __builtin_amdgcn_s_sleep(8); } }
#endif
    }
}

DI void phase3b(const Params& P, int l, unsigned char* sm) {
    const int tid = tidl(), wid = tid >> 6, lane = tid & 63, fr = lane & 15, fq = lane >> 4;
    for (int rowb = blockIdx.x * 8 + wid; rowb < T_; rowb += gridDim.x * 8 * 8) { const int hh = lane >> 4, c = lane * 8;
        u32x4 a0[8], a1[8], a2[8], gv[8]; float inv[8];
#pragma unroll
        for (int q = 0; q < 8; ++q) { const int row = rowb + q * gridDim.x * 8; if (row < T_) {
            a0[q] = *(const u32x4*)(P.y() + (size_t)row * 2048 + 1536 + c); a1[q] = *(const u32x4*)(P.Od4() + (size_t)row * 512 + c); a2[q] = *(const u32x4*)(P.Od16() + (size_t)row * 512 + c); gv[q] = *(const u32x4*)(P.u() + (size_t)row * NINP + U_GD + c);
            inv[q] = P.ldp()[(size_t)row * 4 + hh] + P.ldp()[((size_t)T_ + row) * 4 + hh] + P.ldp()[((size_t)2 * T_ + row) * 4 + hh]; } }
#pragma unroll
        for (int q = 0; q < 8; ++q) { const int row = rowb + q * gridDim.x * 8; if (row < T_) { const float iv = 1.0f / inv[q]; u32x4 o;
            o.x = pk2((lo2f(a0[q].x) + lo2f(a1[q].x) + lo2f(a2[q].x)) * iv * silu_f(lo2f(gv[q].x)), (hi2f(a0[q].x) + hi2f(a1[q].x) + hi2f(a2[q].x)) * iv * silu_f(hi2f(gv[q].x)));
            o.y = pk2((lo2f(a0[q].y) + lo2f(a1[q].y) + lo2f(a2[q].y)) * iv * silu_f(lo2f(gv[q].y)), (hi2f(a0[q].y) + hi2f(a1[q].y) + hi2f(a2[q].y)) * iv * silu_f(hi2f(gv[q].y)));
            o.z = pk2((lo2f(a0[q].z) + lo2f(a1[q].z) + lo2f(a2[q].z)) * iv * silu_f(lo2f(gv[q].z)), (hi2f(a0[q].z) + hi2f(a1[q].z) + hi2f(a2[q].z)) * iv * silu_f(hi2f(gv[q].z)));
            o.w = pk2((lo2f(a0[q].w) + lo2f(a1[q].w) + lo2f(a2[q].w)) * iv * silu_f(lo2f(gv[q].w)), (hi2f(a0[q].w) + hi2f(a1[q].w) + hi2f(a2[q].w)) * iv * silu_f(hi2f(gv[q].w)));
            *(u32x4*)(P.y() + (size_t)row * 2048 + 1536 + c) = o; } }
    }
    for (int it = blockIdx.x; it < 1024; it += gridDim.x) p3b_gla(P, l, it >> 8, (it >> 2) & 63, it & 3, (float*)sm);
    float* yL = (float*)sm;
    bf16_t* CL = (bf16_t*)(sm + 66560); bf16_t* BL = (bf16_t*)(sm + 66560 + 17408); float* GT = (float*)(sm + 66560 + 2 * 17408);
    for (int it = blockIdx.x; it < 512; it += gridDim.x) { const int g = it & 1, c = (it >> 1) & 63, b = it >> 7; const size_t tokb = (size_t)b * S_ + 64 * c;
        const int h = g * 4 + (wid >> 1);
#pragma unroll
        for (int i = 0; i < 4; ++i) { const int u = tid + 512 * i, sel = u >> 10, row = (u >> 4) & 63, c16 = u & 15;
            const u32x4 v = *(const u32x4*)((sel ? P.Bm() : P.Cm()) + (tokb + row) * 256 + g * 128 + c16 * 8); *(u32x4*)((sel ? BL : CL) + row * 136 + c16 * 8) = v; }
        __syncthreads();
#pragma unroll 1
        for (int tix = wid; tix < 10; tix += 8) {
            const int st = tix < 4 ? 0 : (tix < 7 ? 1 : (tix < 9 ? 2 : 3)), lt = tix < 4 ? tix : (tix < 7 ? tix - 3 : (tix < 9 ? tix - 5 : 3));
            f32x4 gacc = fz4();
#pragma unroll
            for (int ks = 0; ks < 4; ++ks) gacc = mfma16(*(const bf16x8*)(BL + (16 * st + fr) * 136 + 32 * ks + 8 * fq), *(const bf16x8*)(CL + (16 * lt + fr) * 136 + 32 * ks + 8 * fq), gacc);
            *(f32x4*)(GT + (st * 4 + lt) * 256 + lane * 4) = gacc; }
        __syncthreads();
        { const int ps0 = (wid & 1) * 2; f32x4 yacc[2][4];
            u32x2 zr[2][4];
#pragma unroll
            for (int p = 0; p < 2; ++p)
#pragma unroll
                for (int lt = 0; lt < 4; ++lt) zr[p][lt] = *(const u32x2*)(P.u() + (tokb + 16 * lt + fr) * NINP + U_GB + g * 256 + (h & 3) * 64 + (ps0 + p) * 16 + 4 * fq);
            ssd_chunk3(P, l, b, c, h, ps0, CL, GT, yacc);
#pragma unroll
            for (int p = 0; p < 2; ++p)
#pragma unroll
                for (int lt = 0; lt < 4; ++lt) { const int tl = 16 * lt + fr, col = (h & 3) * 64 + (ps0 + p) * 16 + 4 * fq;
                    f32x4 z; z[0] = lo2f(zr[p][lt].x); z[1] = hi2f(zr[p][lt].x); z[2] = lo2f(zr[p][lt].y); z[3] = hi2f(zr[p][lt].y); f32x4 v = yacc[p][lt];
                    v[0] *= silu_f(z[0]); v[1] *= silu_f(z[1]); v[2] *= silu_f(z[2]); v[3] *= silu_f(z[3]);
                    *(f32x4*)(yL + tl * 260 + col) = v; } }
        __syncthreads();
        const f32x4 gn = *(const f32x4*)(P.sng + l * 512 + g * 256 + lane * 4);
#pragma unroll 4
        for (int i = 0; i < 8; ++i) { const int tl = wid * 8 + i; const f32x4 v = *(const f32x4*)(yL + tl * 260 + lane * 4);
            const float rs = rsqrtf(wsum(v[0] * v[0] + v[1] * v[1] + v[2] * v[2] + v[3] * v[3]) * (1.0f / 256.0f) + EPS_);
            st4bf(P.y() + (tokb + tl) * 2048 + 512 + g * 256 + lane * 4, v * rs * gn); }
        __syncthreads();
    }
}


DI void phase_rstd(const Params& P) {
    const int tid = tidl();
    for (int row = blockIdx.x * 64 + (tid >> 3); row < T_; row += gridDim.x * 64) {
        const f32x4 v = *(const f32x4*)(P.rowsq() + (size_t)row * 32 + (tid & 7) * 4); float sq = (v[0] + v[1]) + (v[2] + v[3]);
        sq += __shfl_xor(sq, 1); sq += __shfl_xor(sq, 2); sq += __shfl_xor(sq, 4);
        if ((tid & 7) == 0) P.rstd()[row] = rsqrtf(sq * (1.0f / 2048.0f) + EPS_); }
}

#define XB_TMO      128
#define XB_XCNT(j)  (256  + 64 * (j))
#define XB_XSUB(j)  (1280 + 64 * (j))
#define XB_XGEN(j)  (2304 + 64 * (j))
#define XB_TOP      3328
#define XB_TOPGEN   3392
#define XCD_BAR_WORDS 3456
#define XB_SPIN_CAP (1u << 18)
#define XB_LAS __attribute__((address_space(3)))
DI unsigned xb_ld(unsigned* p)              { return __hip_atomic_load(p, __ATOMIC_RELAXED, __HIP_MEMORY_SCOPE_AGENT); }
DI unsigned xb_add(unsigned* p, unsigned v) { return __hip_atomic_fetch_add(p, v, __ATOMIC_RELAXED, __HIP_MEMORY_SCOPE_AGENT); }
DI unsigned xb_xcc_id() { return (unsigned)__builtin_amdgcn_s_getreg((3 << 11) | 20) & 0xFu; }
#define XB_SPIN(cond, bar) do { unsigned _sp = 0; while (cond) { __builtin_amdgcn_s_sleep(1); \
    if ((++_sp & 255u) == 0u) { if (xb_ld(&(bar)[XB_TMO])) break; if (_sp > XB_SPIN_CAP) { atomicAdd(&(bar)[XB_TMO], 1u); break; } } } } while (0)
DI void xcd_barrier_post(unsigned* bar) { if (threadIdx.x == 0) (void)xb_add(&bar[XB_XCNT(xb_xcc_id())], 1u); }
DI void xcd_barrier_complete(unsigned* bar, unsigned x, unsigned& nloc, unsigned& nx) {
    const unsigned G = gridDim.x * gridDim.y * gridDim.z;
    unsigned sum, cnt, mine, sp = 0u;
    for (;;) {
        sum = 0u; cnt = 0u; mine = 0u;
#pragma unroll
        for (unsigned j = 0; j < 16; ++j) { const unsigned c = xb_ld(&bar[XB_XCNT(j)]); sum += c; cnt += (c > 0u) ? 1u : 0u; mine = (j == x) ? c : mine; }
        if (sum == G) break;
        __builtin_amdgcn_s_sleep(1);
        if ((++sp & 255u) == 0u) { if (xb_ld(&bar[XB_TMO])) break; if (sp > XB_SPIN_CAP) { atomicAdd(&bar[XB_TMO], 1u); break; } }
    }
    nloc = mine > 0u ? mine : 1u; nx = cnt > 0u ? cnt : 1u;
}
DI void xcd_barrier(unsigned* bar, volatile XB_LAS unsigned* st) {
    asm volatile("s_waitcnt vmcnt(0)" ::: "memory");
    __syncthreads();
    if (threadIdx.x == 0) {
        const unsigned x = xb_xcc_id();
        __builtin_amdgcn_s_waitcnt(0);
        unsigned nloc = st[0], nx = st[1];
        if (nloc == 0u) { xcd_barrier_complete(bar, x, nloc, nx); st[0] = nloc; st[1] = nx; }
        const unsigned old = xb_add(&bar[XB_XSUB(x)], 1u);
        const unsigned gen = old / nloc;
        if (old + 1u == (gen + 1u) * nloc) {
            __builtin_amdgcn_fence(__ATOMIC_RELEASE, "agent");
            asm volatile("s_waitcnt vmcnt(0)" ::: "memory");
            const unsigned og = xb_add(&bar[XB_TOP], 1u);
            const unsigned tg = og / nx;
            if (og + 1u == (tg + 1u) * nx) xb_add(&bar[XB_TOPGEN], 1u);
            else XB_SPIN(xb_ld(&bar[XB_TOPGEN]) == tg, bar);
            __builtin_amdgcn_fence(__ATOMIC_ACQUIRE, "agent");
            xb_add(&bar[XB_XGEN(x)], 1u);
            asm volatile("s_waitcnt vmcnt(0)" ::: "memory");
        } else {
            XB_SPIN(xb_ld(&bar[XB_XGEN(x)]) == gen, bar);
            __builtin_amdgcn_fence(__ATOMIC_ACQUIRE, "agent");
            asm volatile("s_waitcnt vmcnt(0)" ::: "memory");
        }
    }
    __syncthreads();
}

extern __shared__ __attribute__((aligned(16))) unsigned char smem[];
__global__ __launch_bounds__(512, 2) void mk_fwd(Params Pk) {
    __shared__ int s_item;
    __shared__ uint4 xb_words;
#ifndef ONLY_S
#define ONLY_S -1
#endif
    if (Pk.ph_hi > Pk.ph_lo) { if (threadIdx.x == 0) xb_words = make_uint4(0u, 0u, 0u, 0u); __syncthreads(); xcd_barrier_post(Pk.bar()); }
    for (int phi = Pk.ph_lo; phi <= Pk.ph_hi; ++phi) {
        if (Pk.ph_lo < -1000) cg::this_grid().sync();
        if (phi > Pk.ph_lo) xcd_barrier(Pk.bar(), (volatile XB_LAS unsigned*)&xb_words);
        Params P = Pk; int ph = phi; size_t z0 = 0, z1 = 0;
        asm volatile("" : "+s"(z0), "+s"(z1), "+s"(ph));
        P.ws = Pk.ws + z0; P.out = Pk.out + z1;
        if (ph == 0) { if (ONLY_S < 0 || ONLY_S == 9) phase0(P, smem); continue; }
        const int l = (ph - 1) / 6, s = (ph - 1) % 6;
#ifdef PROBE_S
        const unsigned long long pt0 = wall_clock64();
#endif
        if (s == 0) { if (ONLY_S < 0 || ONLY_S == 0) {
            pg8::Gemm g; g.A = P.xb(); g.Bt = P.WinT() + (size_t)l * NINP * 2048; g.M = T_; g.N = NINP; g.K = 2048;
            pg8::StaticOrder so; so.init(g.M, g.N, (int)gridDim.x, (int)blockIdx.x);
            EpiIn e; e.U = P.u(); e.rstd = P.rstd();
            pg8::gemm_phase<EpiIn, pg8::StaticOrder>((PG8_LAS unsigned char*)smem, g, so, e);
            if (l + 1 < NLAYER && blockIdx.x >= 64 && gridDim.x > 64) { __syncthreads(); convert_weights(P, smem, (l + 1) * TILES_PER_LAYER, (l + 2) * TILES_PER_LAYER, (int)blockIdx.x - 64, (int)gridDim.x - 64); } }
        } else if (s == 1) { if (ONLY_S < 0 || ONLY_S == 1) phase2(P, l, smem); }
        else if (s == 2) { if (ONLY_S < 0 || ONLY_S == 2) phase3(P, l, smem, &s_item); }
        else if (s == 3) { if (ONLY_S < 0 || ONLY_S == 3) phase3b(P, l, smem); }
        else if (s == 5) { if (l + 1 < NLAYER) phase_rstd(P); }
        else if (ONLY_S < 0 || ONLY_S == 4) {
            pg8::Gemm g; g.A = P.y(); g.Bt = P.WoutT() + (size_t)l * 2048 * 2048; g.M = T_; g.N = 2048; g.K = 2048;
            pg8::StaticOrder so; so.init(g.M, g.N, (int)gridDim.x, (int)blockIdx.x);
            EpiOut e; e.xin = (l == 0) ? P.x : P.out; e.xout = P.out; e.xb = P.xb(); e.rsq = (l + 1 < NLAYER) ? P.rowsq() : nullptr;
#ifndef P4_STAGGER
#define P4_STAGGER 0
#endif
            if (P4_STAGGER > 0 && (blockIdx.x & 8)) { const unsigned long long w0 = wall_clock64(); while (wall_clock64() - w0 < (unsigned long long)P4_STAGGER) __builtin_amdgcn_s_sleep(8); }
            pg8::gemm_phase<EpiOut, pg8::StaticOrder>((PG8_LAS unsigned char*)smem, g, so, e);
        }
#ifdef PROBE_S
        if (s == PROBE_S) { cg::this_grid().sync(); const unsigned long long pt1 = wall_clock64(); while (wall_clock64() - pt1 < pt1 - pt0) __builtin_amdgcn_s_sleep(8); }
#endif
    }
}

extern "C" void kernel_launch(void* const* d_in, const int* in_sizes, int n_in, void* d_out, int out_size, void* d_ws, size_t ws_size, hipStream_t stream) {
    (void)in_sizes; (void)n_in; (void)out_size;
    Params p{};
    p.x = (const float*)d_in[0]; p.pos = (const int*)d_in[1]; p.ln_g = (const float*)d_in[2]; p.w_in = (const float*)d_in[3]; p.w_out = (const float*)d_in[4];
    p.gw2 = (const float*)d_in[5]; p.gb = (const float*)d_in[6]; p.gng = (const float*)d_in[7]; p.cw = (const float*)d_in[8]; p.cb = (const float*)d_in[9];
    p.dtb = (const float*)d_in[10]; p.alog = (const float*)d_in[11]; p.sD = (const float*)d_in[12]; p.sng = (const float*)d_in[13]; p.qng = (const float*)d_in[14];
    p.kvng = (const float*)d_in[15]; p.wuq = (const float*)d_in[16]; p.wukv = (const float*)d_in[17]; p.qhg = (const float*)d_in[18]; p.khg = (const float*)d_in[19];
    p.dqg = (const float*)d_in[20]; p.dkg = (const float*)d_in[21];
    p.out = (float*)d_out;
    p.ws = (unsigned char*)d_ws;
    if (WS_TOTAL > ws_size) { fprintf(stderr, "workspace too small: need %zu have %zu\n", (size_t)WS_TOTAL, ws_size); return; }
    static bool attr = false;
    if (!attr) { hipFuncSetAttribute((const void*)mk_fwd, hipFuncAttributeMaxDynamicSharedMemorySize, LDS_BYTES); attr = true; }
    const int NPH = 6 * NLAYER;
#if MK_MULTI
    for (int ph = 0; ph < NPH; ++ph) { p.ph_lo = ph; p.ph_hi = ph; hipLaunchKernelGGL(mk_fwd, dim3(256), dim3(512), LDS_BYTES, stream, p); }
#else
    static int grid_blocks = 0;
    if (!grid_blocks) { int dev = 0, cus = 0, per_cu = 0; hipGetDevice(&dev); hipDeviceGetAttribute(&cus, hipDeviceAttributeMultiprocessorCount, dev);
        hipOccupancyMaxActiveBlocksPerMultiprocessor(&per_cu, mk_fwd, 512, LDS_BYTES); if (per_cu < 1) per_cu = 1; if (per_cu > 1) per_cu = 1; grid_blocks = cus * per_cu; }
    p.ph_lo = 0; p.ph_hi = NPH - 1;
    (void)hipMemsetAsync((unsigned char*)d_ws + OFF_ctr + 256, 0, (size_t)XCD_BAR_WORDS * 4, stream);
    void* args[] = {&p};
    hipError_t e = hipLaunchCooperativeKernel((void*)mk_fwd, dim3(grid_blocks), dim3(512), args, LDS_BYTES, stream);
    if (e != hipSuccess) fprintf(stderr, "cooperative launch failed: %s (grid %d)\n", hipGetErrorString(e), grid_blocks);
#endif
}
```

```cpp
#include <hip/hip_runtime.h>
#include <hip/hip_cooperative_groups.h>
#include <cstdio>
#include <cstdint>
namespace cg = cooperative_groups;
#ifndef MK_MULTI
#define MK_MULTI 0
#endif
namespace pg8 {
#define PG8_LAS __attribute__((address_space(3)))
typedef unsigned short bf16_t;
typedef short bf16x8 __attribute__((ext_vector_type(8)));
typedef float f32x4 __attribute__((ext_vector_type(4)));
typedef unsigned u32x4 __attribute__((ext_vector_type(4)));
constexpr int BM = 256, BK = 64, HALF = 128, HTB = HALF * BK * 2  , STAGE_BYTES = 8 * HTB, NXCD = 8, WGM = 8;

__host__ __device__ __forceinline__ int lds_byte(int r, int c) { const int st = (r >> 4) * 2 + (c >> 5), rr = r & 15, cc = c & 31, ob = rr * 64 + cc * 2; return st * 1024 + (ob ^ (((ob >> 9) & 1) << 5)); }
__host__ __device__ __forceinline__ void stage_rc(int b, int& R, int& C) { const int st = b / 1024, sb = b % 1024, swz = sb ^ (((sb >> 9) & 1) << 5); R = (st >> 1) * 16 + swz / 64; C = (st & 1) * 32 + (swz % 64) / 2; }
__host__ __device__ __forceinline__ int perm32(int rho) { const int n = rho >> 4, i = rho & 15; return 8 * (i >> 2) + 4 * n + (i & 3); }

struct Unit { int pm, pn; };
struct Gemm { const bf16_t* A; const bf16_t* Bt; int M, N, K; };

struct StaticOrder {
    int nM, nN, nwg, G, c;
    __host__ __device__ void init(int M, int N, int G_, int c_) { nM = M / BM; nN = N / BM; nwg = nM * nN; G = G_; c = c_; }
    __host__ __device__ bool next(int i, Unit& u) const {
        const long L = (long)i * G + c; if (L >= nwg) return false;
        int wgid = (int)L; { const int q = nwg / NXCD, r = nwg % NXCD, xcd = wgid % NXCD, off = wgid / NXCD; wgid = (xcd < r ? xcd * (q + 1) : r * (q + 1) + (xcd - r) * q) + off; }
        const int nig = WGM * nN, gid = wgid / nig, fm = gid * WGM, gsz = (nM - fm) < WGM ? (nM - fm) : WGM;
        u.pm = fm + ((wgid % nig) % gsz); u.pn = (wgid % nig) / gsz; return true;
    }
    __device__ __forceinline__ void a_ready(const Unit&) const {}
    __device__ __forceinline__ void done(const Unit&) const {}
};
template <class Epi, class Sched>
__device__ __forceinline__ void gemm_phase(PG8_LAS unsigned char* lds, const Gemm g, const Sched& S, const Epi& E) {
    int tid_ = threadIdx.x; asm volatile("" : "+v"(tid_));
    const int tid = tid_, wid = __builtin_amdgcn_readfirstlane(tid >> 6), lane = tid & 63, wr = wid >> 2, wc = wid & 3, fr = lane & 15, fq = lane >> 4;
    const int K = g.K, nt = K / BK;
    unsigned voffA[2], voffB[2];
#pragma unroll
    for (int i = 0; i < 2; ++i) { int R, C; stage_rc(tid * 16 + i * 8192, R, C); const int Rb = Epi::PERM ? ((R & ~31) + perm32(R & 31)) : R;
        voffA[i] = (unsigned)(R * K + C) * 2u; voffB[i] = (unsigned)(Rb * K + C) * 2u; }
    const size_t kstep = (size_t)(BK * 2);
    const size_t hstep = (size_t)HALF * K * 2;
    const size_t tstep = 2 * hstep;
    const unsigned ldsw = (unsigned)wid * 1024u;
    const int aoff = lds_byte(wr * 64 + fr, fq * 8), boff = lds_byte(wc * 32 + fr, fq * 8);
#define PG8_SA(b, h) (((b) * 2 + (h)) * HTB)
#define PG8_SB(b, h) ((4 + (b) * 2 + (h)) * HTB)
#define PG8_STAGE(bufoff, gbase, voff) do { _Pragma("unroll") for (int _i = 0; _i < 2; ++_i) \
        __builtin_amdgcn_global_load_lds((const unsigned*)((const char*)(gbase) + (voff)[_i]), (PG8_LAS unsigned*)(lds + (bufoff) + ldsw + _i * 8192), 16, 0, 0); } while (0)
#define PG8_LDA(dst, b, h) do { _Pragma("unroll") for (int m = 0; m < 4; ++m) _Pragma("unroll") for (int k = 0; k < 2; ++k) dst[m][k] = *(const PG8_LAS bf16x8*)(lds + PG8_SA(b, h) + aoff + m * 2048 + k * 1024); } while (0)
#define PG8_LDB(dst, b, h) do { _Pragma("unroll") for (int n = 0; n < 2; ++n) _Pragma("unroll") for (int k = 0; k < 2; ++k) dst[n][k] = *(const PG8_LAS bf16x8*)(lds + PG8_SB(b, h) + boff + n * 2048 + k * 1024); } while (0)
#define PG8_MMA(ai, bj, At, Bt) do { __builtin_amdgcn_s_setprio(1); _Pragma("unroll") for (int m = 0; m < 4; ++m) _Pragma("unroll") for (int n = 0; n < 2; ++n) _Pragma("unroll") for (int k = 0; k < 2; ++k) \
        acc[ai][bj][m][n] = __builtin_amdgcn_mfma_f32_16x16x32_bf16(Bt[n][k], At[m][k], acc[ai][bj][m][n], 0, 0, 0); __builtin_amdgcn_s_setprio(0); } while (0)
#define PG8_WAIT_V(n) asm volatile("s_waitcnt vmcnt(" #n ")" ::: "memory")
#define PG8_WAIT_L(n) asm volatile("s_waitcnt lgkmcnt(" #n ")" ::: "memory")
#define PG8_BAR __builtin_amdgcn_s_barrier()
#define PG8_SCHED __builtin_amdgcn_sched_barrier(0)
    Unit cur, nxt; int ui = 0;
    if (!S.next(0, cur)) return;
    f32x4 acc[2][2][4][2];
#pragma unroll
    for (int a = 0; a < 2; ++a)
#pragma unroll
        for (int b = 0; b < 2; ++b)
#pragma unroll
            for (int m = 0; m < 4; ++m)
#pragma unroll
                for (int n = 0; n < 2; ++n) acc[a][b][m][n] = (f32x4){0.f, 0.f, 0.f, 0.f};
    bf16x8 At[4][2], B0[2][2], B1[2][2];
    const char* cA = (const char*)g.A + (size_t)cur.pm * tstep; const char* cB = (const char*)g.Bt + (size_t)cur.pn * tstep;
    S.a_ready(cur);
    PG8_STAGE(PG8_SB(0, 0), cB, voffB); PG8_STAGE(PG8_SA(0, 0), cA, voffA); PG8_STAGE(PG8_SB(0, 1), cB + hstep, voffB); PG8_STAGE(PG8_SA(0, 1), cA + hstep, voffA);
    if (wr == 1) PG8_BAR;
    PG8_WAIT_V(4); PG8_BAR;
    PG8_STAGE(PG8_SB(1, 0), cB + kstep, voffB); PG8_STAGE(PG8_SA(1, 0), cA + kstep, voffA); PG8_STAGE(PG8_SB(1, 1), cB + hstep + kstep, voffB);
    PG8_WAIT_V(6); PG8_BAR;
    for (;;) {
        const bool has_next = S.next(ui + 1, nxt);
        const char* nA = has_next ? (const char*)g.A + (size_t)nxt.pm * tstep : cA; const char* nB = has_next ? (const char*)g.Bt + (size_t)nxt.pn * tstep : cB;
        for (int t = 0; t < nt; t += 2) {
            const bool last = (t == nt - 2);
            const char* a1 = cA + (size_t)(t + 1) * kstep;
            const char* a2 = last ? nA : cA + (size_t)(t + 2) * kstep; const char* b2 = last ? nB : cB + (size_t)(t + 2) * kstep;
            const char* a3 = a2 + kstep; const char* b3 = b2 + kstep;
            if (last && has_next) S.a_ready(nxt);
            PG8_LDB(B0, 0, 0); PG8_SCHED; PG8_LDA(At, 0, 0); PG8_STAGE(PG8_SA(1, 1), a1 + hstep, voffA);
            PG8_WAIT_L(8); PG8_BAR; PG8_WAIT_L(0); PG8_MMA(0, 0, At, B0); PG8_BAR; PG8_SCHED;
            PG8_LDB(B1, 0, 1); PG8_STAGE(PG8_SB(0, 0), b2, voffB);
            PG8_BAR; PG8_WAIT_L(0); PG8_MMA(0, 1, At, B1); PG8_BAR;
            PG8_LDA(At, 0, 1); PG8_STAGE(PG8_SA(0, 0), a2, voffA);
            PG8_BAR; PG8_WAIT_L(0); PG8_MMA(1, 0, At, B0); PG8_BAR; PG8_SCHED;
            PG8_STAGE(PG8_SB(0, 1), b2 + hstep, voffB);
            PG8_WAIT_V(6); PG8_BAR; PG8_MMA(1, 1, At, B1); PG8_BAR;
            PG8_LDB(B0, 1, 0); PG8_SCHED; PG8_LDA(At, 1, 0); PG8_STAGE(PG8_SA(0, 1), a2 + hstep, voffA);
            PG8_WAIT_L(8); PG8_BAR; PG8_WAIT_L(0); PG8_MMA(0, 0, At, B0); PG8_BAR; PG8_SCHED;
            PG8_LDB(B1, 1, 1); PG8_STAGE(PG8_SB(1, 0), b3, voffB);
            PG8_BAR; PG8_WAIT_L(0); PG8_MMA(0, 1, At, B1); PG8_BAR;
            PG8_LDA(At, 1, 1); PG8_STAGE(PG8_SA(1, 0), a3, voffA);
            PG8_BAR; PG8_WAIT_L(0); PG8_MMA(1, 0, At, B0); PG8_BAR; PG8_SCHED;
            PG8_STAGE(PG8_SB(1, 1), b3 + hstep, voffB);
            PG8_WAIT_V(6); PG8_BAR; PG8_MMA(1, 1, At, B1); PG8_BAR;
        }
        if constexpr (!Epi::AFTER_DRAIN) { E(acc, cur, wr, wc, fr, fq); S.done(cur); }
        if (!has_next) break;
#pragma unroll
        for (int a = 0; a < 2; ++a)
#pragma unroll
            for (int b = 0; b < 2; ++b)
#pragma unroll
                for (int m = 0; m < 4; ++m)
#pragma unroll
                    for (int n = 0; n < 2; ++n) acc[a][b][m][n] = (f32x4){0.f, 0.f, 0.f, 0.f};
        cur = nxt; cA = nA; cB = nB; ++ui;
    }
    PG8_WAIT_V(0);
    if (wr == 0) PG8_BAR;
    PG8_BAR;
    if constexpr (Epi::AFTER_DRAIN) { E.fused(acc, cur, wr, wc, fr, fq, lds, wid, lane); S.done(cur); }
#undef PG8_SA
#undef PG8_SB
#undef PG8_STAGE
#undef PG8_LDA
#undef PG8_LDB
#undef PG8_MMA
#undef PG8_WAIT_V
#undef PG8_WAIT_L
#undef PG8_BAR
#undef PG8_SCHED
}
}

#define DI __device__ __forceinline__
using pg8::bf16_t; using pg8::bf16x8; using pg8::f32x4; using pg8::u32x4;
typedef short s16x4 __attribute__((ext_vector_type(4)));
typedef unsigned u32x2 __attribute__((ext_vector_type(2)));
typedef __bf16 bf16v2 __attribute__((ext_vector_type(2)));
constexpr int T_ = 16384, S_ = 4096, NINP = 6400, NIN = 6232, NLAYER = 4;
constexpr int U_GA = 0, U_GB = 512, U_GC = 1024, U_GD = 1536, U_AQ = 2048, U_AK = 2304, U_AV = 2560, U_ALR = 3072,
              U_XBC = 3088, U_DT = 4112, U_CQ = 4120, U_CKV = 4504, U_CKR = 4632, U_DQ = 4696, U_DK = 5208, U_DV = 5720;
constexpr float EPS_ = 1e-6f, LOG2E = 1.4426950408889634f;
constexpr int LDS_BYTES = 131072;
constexpr int P3_NITEMS = 256 + 64 + 128 + 1536;

constexpr size_t SZ_WinT = (size_t)(NLAYER*(size_t)NINP*(size_t)2048*(size_t)2), OFF_WinT = 0;
constexpr size_t SZ_WoutT = (size_t)(NLAYER*(size_t)2048*(size_t)2048*(size_t)2), OFF_WoutT = OFF_WinT + ((SZ_WinT + 255) & ~(size_t)255);
constexpr size_t SZ_WuqT = (size_t)(NLAYER*(size_t)768*(size_t)384*(size_t)2), OFF_WuqT = OFF_WoutT + ((SZ_WoutT + 255) & ~(size_t)255);
constexpr size_t SZ_WukvT = (size_t)(NLAYER*(size_t)1024*(size_t)128*(size_t)2), OFF_WukvT = OFF_WuqT + ((SZ_WuqT + 255) & ~(size_t)255);
constexpr size_t SZ_u = (size_t)(T_*(size_t)NINP*(size_t)2), OFF_u = OFF_WukvT + ((SZ_WukvT + 255) & ~(size_t)255);
constexpr size_t SZ_y = (size_t)(T_*(size_t)2048*(size_t)2), OFF_y = OFF_u + ((SZ_u + 255) & ~(size_t)255);
constexpr size_t SZ_rowsq = (size_t)(T_*(size_t)32*(size_t)4), OFF_rowsq = OFF_y + ((SZ_y + 255) & ~(size_t)255);
constexpr size_t SZ_cosM = (size_t)(T_*(size_t)32*(size_t)4), OFF_cosM = OFF_rowsq + ((SZ_rowsq + 255) & ~(size_t)255);
constexpr size_t SZ_sinM = (size_t)(T_*(size_t)32*(size_t)4), OFF_sinM = OFF_cosM + ((SZ_cosM + 255) & ~(size_t)255);
constexpr size_t SZ_cosD = (size_t)(T_*(size_t)64*(size_t)4), OFF_cosD = OFF_sinM + ((SZ_sinM + 255) & ~(size_t)255);
constexpr size_t SZ_sinD = (size_t)(T_*(size_t)64*(size_t)4), OFF_sinD = OFF_cosD + ((SZ_cosD + 255) & ~(size_t)255);
constexpr size_t SZ_Qe = (size_t)(T_*(size_t)256*(size_t)2), OFF_Qe = OFF_sinD + ((SZ_sinD + 255) & ~(size_t)255);
constexpr size_t SZ_KdT = (size_t)(T_*(size_t)256*(size_t)2), OFF_KdT = OFF_Qe + ((SZ_Qe + 255) & ~(size_t)255);
constexpr size_t SZ_gvT = (size_t)(T_*(size_t)512*(size_t)2), OFF_gvT = OFF_KdT + ((SZ_KdT + 255) & ~(size_t)255);
constexpr size_t SZ_dec = (size_t)((T_/16)*(size_t)256*(size_t)4), OFF_dec = OFF_gvT + ((SZ_gvT + 255) & ~(size_t)255);
constexpr size_t SZ_ogla = (size_t)(T_*(size_t)512*(size_t)4), OFF_ogla = OFF_dec + ((SZ_dec + 255) & ~(size_t)255);
constexpr size_t SZ_yssd = (size_t)(T_*(size_t)512*(size_t)4), OFF_yssd = OFF_ogla + ((SZ_ogla + 255) & ~(size_t)255);
constexpr size_t SZ_xs = (size_t)(T_*(size_t)512*(size_t)2), OFF_xs = OFF_yssd + ((SZ_yssd + 255) & ~(size_t)255);
constexpr size_t SZ_Bm = (size_t)(T_*(size_t)256*(size_t)2), OFF_Bm = OFF_xs + ((SZ_xs + 255) & ~(size_t)255);
constexpr size_t SZ_Cm = (size_t)(T_*(size_t)256*(size_t)2), OFF_Cm = OFF_Bm + ((SZ_Bm + 255) & ~(size_t)255);
constexpr size_t SZ_BmT = (size_t)(T_*(size_t)1024*(size_t)2), OFF_BmT = OFF_Cm + ((SZ_Cm + 255) & ~(size_t)255);
constexpr size_t SZ_XdT = (size_t)(T_*(size_t)1024*(size_t)2), OFF_XdT = OFF_BmT + ((SZ_BmT + 255) & ~(size_t)255);
constexpr size_t SZ_XdtT = (size_t)(T_*(size_t)512*(size_t)2), OFF_XdtT = OFF_XdT + ((SZ_XdT + 255) & ~(size_t)255);
constexpr size_t SZ_Acs = (size_t)(T_*(size_t)8*(size_t)4), OFF_Acs = OFF_XdtT + ((SZ_XdtT + 255) & ~(size_t)255);
constexpr size_t SZ_Qc = (size_t)(T_*(size_t)768*(size_t)2), OFF_Qc = OFF_Acs + ((SZ_Acs + 255) & ~(size_t)255);
constexpr size_t SZ_Kc = (size_t)(T_*(size_t)768*(size_t)2), OFF_Kc = OFF_Qc + ((SZ_Qc + 255) & ~(size_t)255);
constexpr size_t SZ_Vct = (size_t)(T_*(size_t)512*(size_t)2), OFF_Vct = OFF_Kc + ((SZ_Kc + 255) & ~(size_t)255);
constexpr size_t SZ_dq = (size_t)(T_*(size_t)512*(size_t)2), OFF_dq = OFF_Vct + ((SZ_Vct + 255) & ~(size_t)255);
constexpr size_t SZ_dk = (size_t)(T_*(size_t)512*(size_t)2), OFF_dk = OFF_dq + ((SZ_dq + 255) & ~(size_t)255);
constexpr size_t SZ_Vt1 = (size_t)(T_*(size_t)512*(size_t)2), OFF_Vt1 = OFF_dk + ((SZ_dk + 255) & ~(size_t)255);
constexpr size_t SZ_Vt4 = (size_t)(T_*(size_t)512*(size_t)2), OFF_Vt4 = OFF_Vt1 + ((SZ_Vt1 + 255) & ~(size_t)255);
constexpr size_t SZ_Vt16 = (size_t)(T_*(size_t)512*(size_t)2), OFF_Vt16 = OFF_Vt4 + ((SZ_Vt4 + 255) & ~(size_t)255);
constexpr size_t SZ_ctr = (size_t)(256 + 3456*(size_t)4 + 65536 + 262144), OFF_ctr = OFF_Vt16 + ((SZ_Vt16 + 255) & ~(size_t)255);
constexpr size_t WS_TOTAL = OFF_ctr + ((SZ_ctr + 255) & ~(size_t)255);
struct Params {
    const float *x, *ln_g, *w_in, *w_out, *gw2, *gb, *gng, *cw, *cb, *dtb, *alog, *sD, *sng, *qng, *kvng, *wuq, *wukv, *qhg, *khg, *dqg, *dkg;
    const int* pos;
    float* out;
    unsigned char* ws;
    int ph_lo, ph_hi;
    __device__ __forceinline__ bf16_t* WinT() const { return (bf16_t*)(ws + OFF_WinT); }
    __device__ __forceinline__ bf16_t* WoutT() const { return (bf16_t*)(ws + OFF_WoutT); }
    __device__ __forceinline__ bf16_t* WuqT() const { return (bf16_t*)(ws + OFF_WuqT); }
    __device__ __forceinline__ bf16_t* WukvT() const { return (bf16_t*)(ws + OFF_WukvT); }
    __device__ __forceinline__ bf16_t* u() const { return (bf16_t*)(ws + OFF_u); }
    __device__ __forceinline__ bf16_t* y() const { return (bf16_t*)(ws + OFF_y); }
    __device__ __forceinline__ float* rowsq() const { return (float*)(ws + OFF_rowsq); }
    __device__ __forceinline__ float* cosM() const { return (float*)(ws + OFF_cosM); }
    __device__ __forceinline__ float* sinM() const { return (float*)(ws + OFF_sinM); }
    __device__ __forceinline__ float* cosD() const { return (float*)(ws + OFF_cosD); }
    __device__ __forceinline__ float* sinD() const { return (float*)(ws + OFF_sinD); }
    __device__ __forceinline__ bf16_t* Qe() const { return (bf16_t*)(ws + OFF_Qe); }
    __device__ __forceinline__ bf16_t* KdT() const { return (bf16_t*)(ws + OFF_KdT); }
    __device__ __forceinline__ bf16_t* gvT() const { return (bf16_t*)(ws + OFF_gvT); }
    __device__ __forceinline__ float* dec() const { return (float*)(ws + OFF_dec); }
    __device__ __forceinline__ bf16_t* ogla() const { return (bf16_t*)(ws + OFF_ogla); }
    __device__ __forceinline__ float* yssd() const { return (float*)(ws + OFF_yssd); }
    __device__ __forceinline__ bf16_t* xs() const { return (bf16_t*)(ws + OFF_xs); }
    __device__ __forceinline__ bf16_t* Bm() const { return (bf16_t*)(ws + OFF_Bm); }
    __device__ __forceinline__ bf16_t* Cm() const { return (bf16_t*)(ws + OFF_Cm); }
    __device__ __forceinline__ bf16_t* Pv() const { return (bf16_t*)(ws + OFF_XdT); }
    __device__ __forceinline__ bf16_t* Od4() const { return (bf16_t*)(ws + OFF_BmT); }
    __device__ __forceinline__ bf16_t* Od16() const { return (bf16_t*)(ws + OFF_BmT + SZ_BmT / 2); }
    __device__ __forceinline__ bf16_t* Sg() const { return (bf16_t*)(ws + OFF_XdT); }
    __device__ __forceinline__ bf16_t* XdtT() const { return (bf16_t*)(ws + OFF_XdtT); }
    __device__ __forceinline__ float* Acs() const { return (float*)(ws + OFF_Acs); }
    __device__ __forceinline__ bf16_t* Qc() const { return (bf16_t*)(ws + OFF_Qc); }
    __device__ __forceinline__ bf16_t* Kc() const { return (bf16_t*)(ws + OFF_Kc); }
    __device__ __forceinline__ bf16_t* Vct() const { return (bf16_t*)(ws + OFF_Vct); }
    __device__ __forceinline__ bf16_t* dq() const { return (bf16_t*)(ws + OFF_dq); }
    __device__ __forceinline__ bf16_t* dk() const { return (bf16_t*)(ws + OFF_dk); }
    __device__ __forceinline__ bf16_t* Vt1() const { return (bf16_t*)(ws + OFF_Vt1); }
    __device__ __forceinline__ bf16_t* Vt4() const { return (bf16_t*)(ws + OFF_Vt4); }
    __device__ __forceinline__ bf16_t* Vt16() const { return (bf16_t*)(ws + OFF_Vt16); }
    __device__ __forceinline__ unsigned* ctr() const { return (unsigned*)(ws + OFF_ctr); }
    __device__ __forceinline__ unsigned* bar() const { return (unsigned*)(ws + OFF_ctr + 256); }
    __device__ __forceinline__ float* rstd() const { return (float*)(ws + OFF_ctr + 256 + 3456 * 4); }
    __device__ __forceinline__ float* Dt() const { return (float*)(ws + OFF_ctr + 256 + 3456 * 4 + 65536); }
    __device__ __forceinline__ bf16_t* Lg() const { return (bf16_t*)(ws + OFF_yssd); }
    __device__ __forceinline__ bf16_t* Sst() const { return (bf16_t*)(ws + OFF_yssd); }
    __device__ __forceinline__ float* ldp() const { return (float*)(ws + OFF_yssd + SZ_yssd / 2); }
    __device__ __forceinline__ bf16_t* xb() const { return (bf16_t*)(ws + OFF_ogla); }
};

DI const bf16_t* launder_p(const bf16_t* p) { int z = 0; asm volatile("" : "+v"(z)); return p + z; }
DI int tidl() { int t = threadIdx.x; asm volatile("" : "+v"(t)); return t; }
DI float bf2f(bf16_t h) { return __uint_as_float((unsigned)h << 16); }
DI unsigned pk2(float lo, float hi) { bf16v2 v = {(__bf16)lo, (__bf16)hi}; return __builtin_bit_cast(unsigned, v); }
DI bf16_t f2bf(float x) { return (bf16_t)(pk2(x, 0.f) & 0xffffu); }
DI float lo2f(unsigned w) { return __uint_as_float(w << 16); }
DI float hi2f(unsigned w) { return __uint_as_float(w & 0xffff0000u); }
DI float wsum(float v) {
#pragma unroll
    for (int o = 32; o; o >>= 1) v += __shfl_xor(v, o);
    return v; }
DI float wmaxf(float v) {
#pragma unroll
    for (int o = 32; o; o >>= 1) v = fmaxf(v, __shfl_xor(v, o));
    return v; }
DI float silu_f(float x) { return x / (1.f + __expf(-x)); }
DI bf16x8 pack8(f32x4 a, f32x4 b) { u32x4 w; w.x = pk2(a[0], a[1]); w.y = pk2(a[2], a[3]); w.z = pk2(b[0], b[1]); w.w = pk2(b[2], b[3]); return __builtin_bit_cast(bf16x8, w); }
DI bf16x8 cat4(s16x4 a, s16x4 b) { bf16x8 r; r[0] = a[0]; r[1] = a[1]; r[2] = a[2]; r[3] = a[3]; r[4] = b[0]; r[5] = b[1]; r[6] = b[2]; r[7] = b[3]; return r; }
DI bf16x8 zero8() { bf16x8 r = {0, 0, 0, 0, 0, 0, 0, 0}; return r; }
DI s16x4 zero4() { s16x4 r = {0, 0, 0, 0}; return r; }
DI f32x4 fz4() { f32x4 r = {0.f, 0.f, 0.f, 0.f}; return r; }
DI f32x4 mfma16(bf16x8 a, bf16x8 b, f32x4 c) { return __builtin_amdgcn_mfma_f32_16x16x32_bf16(a, b, c, 0, 0, 0); }
DI bf16x8 ldperm(const bf16_t* p, int fq) { return cat4(*(const s16x4*)(p + 4 * fq), *(const s16x4*)(p + 16 + 4 * fq)); }
DI f32x4 ld4bf(const bf16_t* p) { u32x2 w = *(const u32x2*)p; f32x4 r; r[0] = lo2f(w.x); r[1] = hi2f(w.x); r[2] = lo2f(w.y); r[3] = hi2f(w.y); return r; }
DI void st4bf(bf16_t* p, f32x4 v) { u32x2 w; w.x = pk2(v[0], v[1]); w.y = pk2(v[2], v[3]); *(u32x2*)p = w; }

struct EpiIn {
    static constexpr bool PERM = true, AFTER_DRAIN = false;
    bf16_t* U; const float* rstd;
    DI void operator()(const f32x4 (&acc)[2][2][4][2], const pg8::Unit& u, int wr, int wc, int fr, int fq) const {
        const int row0 = u.pm * 256 + wr * 64 + fr, col0 = u.pn * 256 + wc * 32 + 8 * fq;
        float rs[2][4];
#pragma unroll
        for (int ai = 0; ai < 2; ++ai)
#pragma unroll
            for (int m = 0; m < 4; ++m) rs[ai][m] = rstd[row0 + ai * 128 + m * 16];
#pragma unroll
        for (int ai = 0; ai < 2; ++ai)
#pragma unroll
            for (int m = 0; m < 4; ++m) {
                const float r = rs[ai][m];
                bf16_t* rowp = U + (size_t)(row0 + ai * 128 + m * 16) * NINP + col0;
#pragma unroll
                for (int bj = 0; bj < 2; ++bj) {
                    const f32x4 v0 = acc[ai][bj][m][0] * r, v1 = acc[ai][bj][m][1] * r;
                    u32x4 w; w.x = pk2(v0[0], v0[1]); w.y = pk2(v0[2], v0[3]); w.z = pk2(v1[0], v1[1]); w.w = pk2(v1[2], v1[3]);
                    *(u32x4*)(rowp + bj * 128) = w; } }
    }
};
struct EpiOut {
    static constexpr bool PERM = false, AFTER_DRAIN = false;
    const float* xin; float* xout; bf16_t* xb; float* rsq;
    DI void operator()(const f32x4 (&acc)[2][2][4][2], const pg8::Unit& u, int wr, int wc, int fr, int fq) const {
        const int row0 = u.pm * 256 + wr * 64 + fr, col0 = u.pn * 256 + wc * 32 + 4 * fq;
#pragma unroll
        for (int ai = 0; ai < 2; ++ai) {
            f32x4 xv[4][2][2];
#pragma unroll
            for (int m = 0; m < 4; ++m)
#pragma unroll
                for (int bj = 0; bj < 2; ++bj)
#pragma unroll
                    for (int n = 0; n < 2; ++n) xv[m][bj][n] = *(const f32x4*)(xin + (size_t)(row0 + ai * 128 + m * 16) * 2048 + col0 + bj * 128 + n * 16);
            __builtin_amdgcn_sched_barrier(0);
#pragma unroll
            for (int m = 0; m < 4; ++m) {
                const int row = row0 + ai * 128 + m * 16; float ss = 0.f;
#pragma unroll
                for (int bj = 0; bj < 2; ++bj)
#pragma unroll
                    for (int n = 0; n < 2; ++n) {
                        const size_t o = (size_t)row * 2048 + col0 + bj * 128 + n * 16;
                        const f32x4 v = xv[m][bj][n] + acc[ai][bj][m][n];
                        *(f32x4*)(xout + o) = v;
                        if (rsq) { st4bf(xb + o, v); ss += v[0] * v[0] + v[1] * v[1] + v[2] * v[2] + v[3] * v[3]; } }
                if (rsq) { ss += __shfl_xor(ss, 16); ss += __shfl_xor(ss, 32); if (fq == 0) rsq[(size_t)row * 32 + u.pn * 4 + wc] = ss; } } }
    }
};

struct TrJob { const float* src; const float* g; bf16_t* dst; int K, N, k0, n0; };
DI TrJob tr_decode(const Params& P, int it) {
    constexpr int T_IN = 32 * 100, T_OUT = 32 * 32, T_UQ = 6 * 12, T_UKV = 2 * 16, T_L = T_IN + T_OUT + T_UQ + T_UKV;
    TrJob j; const int l = it / T_L; int r = it % T_L;
    if (r < T_IN) { j.src = P.w_in + (size_t)l * 2048 * NIN; j.K = 2048; j.N = NIN; j.g = P.ln_g + l * 2048; j.dst = P.WinT() + (size_t)l * NINP * 2048; j.k0 = (r / 100) * 64; j.n0 = (r % 100) * 64; }
    else if ((r -= T_IN) < T_OUT) { j.src = P.w_out + (size_t)l * 2048 * 2048; j.K = 2048; j.N = 2048; j.g = nullptr; j.dst = P.WoutT() + (size_t)l * 2048 * 2048; j.k0 = (r / 32) * 64; j.n0 = (r % 32) * 64; }
    else if ((r -= T_OUT) < T_UQ) { j.src = P.wuq + (size_t)l * 384 * 768; j.K = 384; j.N = 768; j.g = P.qng + l * 384; j.dst = P.WuqT() + (size_t)l * 768 * 384; j.k0 = (r / 12) * 64; j.n0 = (r % 12) * 64; }
    else { r -= T_UQ; j.src = P.wukv + (size_t)l * 128 * 1024; j.K = 128; j.N = 1024; j.g = P.kvng + l * 128; j.dst = P.WukvT() + (size_t)l * 1024 * 128; j.k0 = (r / 16) * 64; j.n0 = (r % 16) * 64; }
    return j;
}
DI void convert_weights(const Params& P, unsigned char* sm, int t_lo, int t_hi, int bid, int G) {
    float* tile = (float*)sm;
    const int tid = tidl();
    for (int it4 = t_lo + bid * 4; it4 < t_hi; it4 += G * 4) {
        float v[4][8];
#pragma unroll
        for (int q = 0; q < 4; ++q) { const int it = it4 + q; if (it < t_hi) { const TrJob j = tr_decode(P, it);
#pragma unroll
            for (int i = 0; i < 8; ++i) { const int r = (tid >> 6) + 8 * i, nn = tid & 63, k = j.k0 + r, n = j.n0 + nn;
                v[q][i] = (n < j.N) ? j.src[(size_t)k * j.N + n] * (j.g ? j.g[k] : 1.f) : 0.f; } } }
#pragma unroll
        for (int q = 0; q < 4; ++q)
#pragma unroll
            for (int i = 0; i < 8; ++i) tile[q * 4160 + ((tid >> 6) + 8 * i) * 65 + (tid & 63)] = v[q][i];
        __syncthreads();
#pragma unroll
        for (int q = 0; q < 4; ++q) { const int it = it4 + q; if (it < t_hi) { const TrJob j = tr_decode(P, it); const float* tq = tile + q * 4160;
            const int n = tid >> 3, kg = (tid & 7) * 8; u32x4 w;
            w.x = pk2(tq[(kg + 0) * 65 + n], tq[(kg + 1) * 65 + n]); w.y = pk2(tq[(kg + 2) * 65 + n], tq[(kg + 3) * 65 + n]);
            w.z = pk2(tq[(kg + 4) * 65 + n], tq[(kg + 5) * 65 + n]); w.w = pk2(tq[(kg + 6) * 65 + n], tq[(kg + 7) * 65 + n]);
            *(u32x4*)(j.dst + (size_t)(j.n0 + n) * j.K + j.k0 + kg) = w; } }
        __syncthreads();
    }
}
constexpr int TILES_PER_LAYER = 32 * 100 + 32 * 32 + 6 * 12 + 2 * 16;
DI void phase0(const Params& P, unsigned char* sm) {
    const int tid = tidl(), wid = tid >> 6, lane = tid & 63, G = gridDim.x, bid = blockIdx.x;
    convert_weights(P, sm, 0, TILES_PER_LAYER, bid, G);
    for (int rowb = bid * 8 + wid; rowb < T_; rowb += G * 8 * 2) {
        f32x4 v[2][8];
#pragma unroll
        for (int q = 0; q < 2; ++q) { const int row = rowb + q * G * 8; if (row < T_) {
#pragma unroll
            for (int i = 0; i < 8; ++i) v[q][i] = *(const f32x4*)(P.x + (size_t)row * 2048 + lane * 4 + 256 * i); } }
#pragma unroll
        for (int q = 0; q < 2; ++q) { const int row = rowb + q * G * 8; if (row < T_) { float ss = 0.f;
#pragma unroll
            for (int i = 0; i < 8; ++i) { const f32x4 w = v[q][i]; ss += w[0] * w[0] + w[1] * w[1] + w[2] * w[2] + w[3] * w[3]; st4bf(P.xb() + (size_t)row * 2048 + lane * 4 + 256 * i, w); }
            ss = wsum(ss); if (lane == 0) P.rstd()[row] = rsqrtf(ss * (1.0f / 2048.0f) + EPS_); } }
    }
    const int gtid = bid * 512 + tid, gn = G * 512;
    if (gtid < 16) P.ctr()[gtid] = 0u;
    for (int e = gtid; e < T_ * 96; e += gn) {
        const int tok = e / 96, j = e % 96; const double pos = (double)P.pos[tok];
        const bool isM = j < 32; const int jj = isM ? j : j - 32;
        const double invf = (double)expf((-9.210340372f * (float)jj) * (isM ? (2.0f / 64.0f) : (2.0f / 128.0f)));
        double ang = pos * invf; const double kq = rint(ang * 0.15915494309189535); ang = ang - kq * 6.283185307179586;
        const float a = (float)ang; const float c = cosf(a), s = sinf(a);
        if (isM) { P.cosM()[tok * 32 + jj] = c; P.sinM()[tok * 32 + jj] = s; } else { P.cosD()[tok * 64 + jj] = c; P.sinD()[tok * 64 + jj] = s; }
    }
}

DI void tr_out(const bf16_t* tile, int ld, int Wlog, bf16_t* dst, int t0, int d) {
    const int run = 64 / d, W = 1 << Wlog;
    for (int unit = tidl(); unit < W * 8; unit += 512) {
        const int c = unit & (W - 1), pi0 = (unit >> Wlog) * 8; unsigned v[8];
#pragma unroll
        for (int e = 0; e < 8; ++e) { const int pi = pi0 + e, rd = pi / run, off = pi % run; v[e] = tile[(off * d + rd) * ld + c]; }
        u32x4 w; w.x = v[0] | (v[1] << 16); w.y = v[2] | (v[3] << 16); w.z = v[4] | (v[5] << 16); w.w = v[6] | (v[7] << 16);
        *(u32x4*)(dst + (size_t)c * S_ + t0 + pi0) = w; }
}

DI void p2_gla(const Params& P, int l, int b, int t0, unsigned char* sm) {
    bf16_t* QeL = (bf16_t*)sm; bf16_t* KeL = (bf16_t*)(sm + 33792); bf16_t* vL = (bf16_t*)sm; bf16_t* KdL = (bf16_t*)(sm + 67584);
    float* attnL = (float*)(sm + 101376); float* alrL = (float*)(sm + 117760); float* decL = (float*)(sm + 121856);
    const int tid = tidl(); const size_t tokb = (size_t)b * S_ + t0;
    for (int e = tid; e < 1024; e += 512) alrL[e] = bf2f(P.u()[(tokb + (e >> 4)) * NINP + U_ALR + (e & 15)]);
    __syncthreads();
    {
        const int c = tid & 255, half = tid >> 8;
        float w2r[16];
#pragma unroll
        for (int r = 0; r < 16; ++r) w2r[r] = P.gw2[(l * 16 + r) * 256 + c];
        const float bias = P.gb[l * 256 + c];
#pragma unroll
        for (int chh = 0; chh < 2; ++chh) {
            const int ch = half * 2 + chh; float bc[16]; float run = 0.f;
            bf16_t qr[16], kr[16];
#pragma unroll
            for (int i = 0; i < 16; ++i) { const size_t tok = tokb + ch * 16 + i; qr[i] = P.u()[tok * NINP + U_AQ + c]; kr[i] = P.u()[tok * NINP + U_AK + c]; }
#pragma unroll
            for (int i = 0; i < 16; ++i) { const int tl = ch * 16 + i; float pre = bias;
#pragma unroll
                for (int r = 0; r < 16; ++r) pre += alrL[tl * 16 + r] * w2r[r];
                const float ls = fminf(pre, 0.f) - __logf(1.0f + __expf(-fabsf(pre))); run += ls * (1.0f / 16.0f); bc[i] = run; }
            const float bl = run;
#pragma unroll
            for (int i = 0; i < 16; ++i) { const int tl = ch * 16 + i; const size_t tok = tokb + tl;
                const float q = bf2f(qr[i]), k = bf2f(kr[i]);
                const bf16_t qeb = f2bf(q * 0.125f * __expf(bc[i]));
                P.Qe()[tok * 256 + c] = qeb; QeL[tl * 264 + c] = qeb; KeL[tl * 264 + c] = f2bf(k * __expf(-bc[i])); KdL[tl * 264 + c] = f2bf(k * __expf(bl - bc[i])); }
            { const float db = __expf(bl); P.dec()[((size_t)b * 256 + (t0 >> 4) + ch) * 256 + c] = db; decL[ch * 256 + c] = db; }
        }
    }
    __syncthreads();
    if (tid < 256) P.Dt()[((size_t)b * 64 + (t0 >> 6)) * 256 + tid] = (decL[tid] * decL[256 + tid]) * (decL[512 + tid] * decL[768 + tid]);
#pragma unroll 2
    for (int rr = 0; rr < 8; ++rr) { const int e = tid + 512 * rr, combo = e >> 8, i = (e >> 4) & 15, j = e & 15, ch = combo >> 2, h = combo & 3;
        float a = 0.f;
        if (j <= i) { const bf16_t* qp = QeL + (ch * 16 + i) * 264 + h * 64; const bf16_t* kp = KeL + (ch * 16 + j) * 264 + h * 64;
#pragma unroll
            for (int d8 = 0; d8 < 8; ++d8) { const u32x4 qv = *(const u32x4*)(qp + d8 * 8), kv = *(const u32x4*)(kp + d8 * 8);
                a += lo2f(qv.x) * lo2f(kv.x) + hi2f(qv.x) * hi2f(kv.x) + lo2f(qv.y) * lo2f(kv.y) + hi2f(qv.y) * hi2f(kv.y)
                   + lo2f(qv.z) * lo2f(kv.z) + hi2f(qv.z) * hi2f(kv.z) + lo2f(qv.w) * lo2f(kv.w) + hi2f(qv.w) * hi2f(kv.w); } }
        attnL[e] = a; }
    tr_out(KdL, 264, 8, P.KdT() + (size_t)b * 256 * S_, t0, 1);
    __syncthreads();
    for (int e = tid; e < 4096; e += 512) { const int tl = e >> 6, c8 = (e & 63) * 8; *(u32x4*)(vL + tl * 520 + c8) = *(const u32x4*)(P.u() + (tokb + tl) * NINP + U_AV + c8); }
    __syncthreads();
    { const int cc = tid, h = cc >> 7;
      for (int ch = 0; ch < 4; ++ch) { float vv[16];
#pragma unroll
          for (int j = 0; j < 16; ++j) vv[j] = bf2f(vL[(ch * 16 + j) * 520 + cc]);
          const float* ap = attnL + (ch * 4 + h) * 256;
#pragma unroll
          for (int i = 0; i < 16; ++i) { float o = 0.f;
#pragma unroll
              for (int j4 = 0; j4 < 4; ++j4) { const f32x4 av = *(const f32x4*)(ap + i * 16 + j4 * 4); o += av[0] * vv[j4 * 4] + av[1] * vv[j4 * 4 + 1] + av[2] * vv[j4 * 4 + 2] + av[3] * vv[j4 * 4 + 3]; }
              P.ogla()[(tokb + ch * 16 + i) * 512 + cc] = f2bf(o); } } }
    tr_out(vL, 520, 9, P.gvT() + (size_t)b * 512 * S_, t0, 1);
    {
        const int w = tid >> 6, lane = tid & 63, fr = lane & 15, fq = lane >> 4;
#pragma unroll 1
        for (int h = 0; h < 4; ++h) { f32x4 S[4] = {fz4(), fz4(), fz4(), fz4()};
#pragma unroll 1
            for (int ch = 0; ch < 4; ++ch) {
                if (ch > 0) {
#pragma unroll
                    for (int kt = 0; kt < 4; ++kt) S[kt] = S[kt] * *(const f32x4*)(decL + ch * 256 + h * 64 + 16 * kt + 4 * fq); }
                bf16x8 vb = zero8(), ka[4] = {zero8(), zero8(), zero8(), zero8()};
                if (fq < 2) {
#pragma unroll
                    for (int j = 0; j < 8; ++j) { const int tl = ch * 16 + 8 * fq + j; vb[j] = (short)vL[tl * 520 + h * 128 + 16 * w + fr];
#pragma unroll
                        for (int kt = 0; kt < 4; ++kt) ka[kt][j] = (short)KdL[tl * 264 + h * 64 + 16 * kt + fr]; } }
#pragma unroll
                for (int kt = 0; kt < 4; ++kt) S[kt] = mfma16(ka[kt], vb, S[kt]); }
#pragma unroll
            for (int kt = 0; kt < 4; ++kt) st4bf(P.Lg() + (((((size_t)(b * 64 + (t0 >> 6)) * 4 + h) * 4 + kt) * 8 + w) * 256) + lane * 4, S[kt]); }
    }
    __syncthreads();
}

DI void p2_ssd(const Params& P, int l, int b, int t0, unsigned char* sm) {
    bf16_t* xT = (bf16_t*)sm; bf16_t* bT = (bf16_t*)(sm + 73728); float* dtL = (float*)(sm + 110592); float* facL = (float*)(sm + 112640);
    const int tid = tidl(), wid = tid >> 6, lane = tid & 63, fr = lane & 15, fq = lane >> 4; const size_t tokb = (size_t)b * S_ + t0; const int cidx = t0 >> 6;
    { const int h = wid; const float raw = bf2f(P.u()[(tokb + lane) * NINP + U_DT + h]) + P.dtb[l * 8 + h];
      const float dtv = fmaxf(raw, 0.f) + __logf(1.0f + __expf(-fabsf(raw)));
      const float a = -dtv * __expf(P.alog[l * 8 + h]);
      float cs = a;
#pragma unroll
      for (int o = 1; o < 64; o <<= 1) { const float t = __shfl_up(cs, o); if (lane >= o) cs += t; }
      const float last = __shfl(cs, 63);
      dtL[h * 64 + lane] = dtv; facL[h * 64 + lane] = __expf(last - cs);
      P.Acs()[(((size_t)b * 64 + cidx) * 8 + h) * 64 + lane] = cs; }
    __syncthreads();
    { const int ch0 = 2 * tid; float w0[4], w1[4];
#pragma unroll
      for (int j = 0; j < 4; ++j) { w0[j] = P.cw[(l * 4 + j) * 1024 + ch0]; w1[j] = P.cw[(l * 4 + j) * 1024 + ch0 + 1]; }
      const float cb0 = P.cb[l * 1024 + ch0], cb1 = P.cb[l * 1024 + ch0 + 1];
      float a0 = 0.f, a1 = 0.f, a2 = 0.f, b0 = 0.f, b1 = 0.f, b2 = 0.f;
      if (t0 > 0) { const unsigned v0 = *(const unsigned*)(P.u() + (tokb - 3) * NINP + U_XBC + ch0), v1 = *(const unsigned*)(P.u() + (tokb - 2) * NINP + U_XBC + ch0), v2 = *(const unsigned*)(P.u() + (tokb - 1) * NINP + U_XBC + ch0);
          a0 = lo2f(v0); b0 = hi2f(v0); a1 = lo2f(v1); b1 = hi2f(v1); a2 = lo2f(v2); b2 = hi2f(v2); }
      const int role = ch0 < 512 ? 0 : (ch0 < 768 ? 1 : 2), hh = (ch0 >> 6) & 7;
#pragma unroll 1
      for (int tb = 0; tb < 64; tb += 16) { unsigned vv[16];
#pragma unroll
      for (int q = 0; q < 16; ++q) vv[q] = *(const unsigned*)(P.u() + (tokb + tb + q) * NINP + U_XBC + ch0);
#pragma unroll
      for (int q = 0; q < 16; ++q) { const int tl = tb + q; const unsigned v = vv[q]; const float x0 = lo2f(v), x1 = hi2f(v);
          const float c0 = cb0 + a0 * w0[0] + a1 * w0[1] + a2 * w0[2] + x0 * w0[3], c1 = cb1 + b0 * w1[0] + b1 * w1[1] + b2 * w1[2] + x1 * w1[3];
          a0 = a1; a1 = a2; a2 = x0; b0 = b1; b1 = b2; b2 = x1;
          const float s0 = silu_f(c0), s1 = silu_f(c1);
          if (role == 0) { const float dtv = dtL[hh * 64 + tl];
              *(unsigned*)(P.xs() + (tokb + tl) * 512 + ch0) = pk2(s0, s1); xT[ch0 * 72 + tl] = f2bf(s0 * dtv); xT[(ch0 + 1) * 72 + tl] = f2bf(s1 * dtv); }
          else if (role == 1) { const unsigned w = pk2(s0, s1); *(unsigned*)(P.Bm() + (tokb + tl) * 256 + (ch0 - 512)) = w; bT[(ch0 - 512) * 72 + tl] = (bf16_t)(w & 0xffffu); bT[(ch0 - 511) * 72 + tl] = (bf16_t)(w >> 16); }
          else { *(unsigned*)(P.Cm() + (tokb + tl) * 256 + (ch0 - 768)) = pk2(s0, s1); } } } }
    __syncthreads();
    for (int unit = tid; unit < 4096; unit += 512) { const int c = unit >> 3, g8 = (unit & 7) * 8;
        *(u32x4*)(P.XdtT() + ((size_t)b * 512 + c) * S_ + t0 + g8) = *(const u32x4*)(xT + c * 72 + g8); }
    {
        const int h = wid, g = h >> 2;
#pragma unroll 1
        for (int pt = 0; pt < 4; ++pt) {
            bf16x8 bx[2];
#pragma unroll
            for (int ks = 0; ks < 2; ++ks) { const u32x4 raw = *(const u32x4*)(xT + (h * 64 + 16 * pt + fr) * 72 + 32 * ks + 8 * fq);
                const float* fp = facL + h * 64 + 32 * ks + 8 * fq; const f32x4 f0 = *(const f32x4*)fp, f1 = *(const f32x4*)(fp + 4);
                u32x4 w; w.x = pk2(lo2f(raw.x) * f0[0], hi2f(raw.x) * f0[1]); w.y = pk2(lo2f(raw.y) * f0[2], hi2f(raw.y) * f0[3]);
                w.z = pk2(lo2f(raw.z) * f1[0], hi2f(raw.z) * f1[1]); w.w = pk2(lo2f(raw.w) * f1[2], hi2f(raw.w) * f1[3]);
                bx[ks] = __builtin_bit_cast(bf16x8, w); }
#pragma unroll
            for (int nt = 0; nt < 8; ++nt) { f32x4 acc = fz4();
#pragma unroll
                for (int ks = 0; ks < 2; ++ks) acc = mfma16(*(const bf16x8*)(bT + (g * 128 + 16 * nt + fr) * 72 + 32 * ks + 8 * fq), bx[ks], acc);
                st4bf(P.Sg() + ((((size_t)(b * 64 + cidx) * 8 + h) * 8 + nt) * 4 + pt) * 256 + lane * 4, acc); }
        }
    }
    __syncthreads();
}

DI void head_norm_rope_store(f32x4 (&x)[12], const float* hg, const float* cosp, const float* sinp, float scale, bf16_t* dstrow, int fq) {
    float ss = 0.f;
#pragma unroll
    for (int nt = 0; nt < 12; ++nt) ss += x[nt][0] * x[nt][0] + x[nt][1] * x[nt][1] + x[nt][2] * x[nt][2] + x[nt][3] * x[nt][3];
    ss += __shfl_xor(ss, 16); ss += __shfl_xor(ss, 32);
    const float rs = rsqrtf(ss * (1.0f / 192.0f) + EPS_);
#pragma unroll
    for (int nt = 0; nt < 12; ++nt) { const f32x4 g = *(const f32x4*)(hg + nt * 16 + fq * 4); x[nt] = x[nt] * rs * g; }
#pragma unroll
    for (int nt = 8; nt < 10; ++nt) { const f32x4 c = *(const f32x4*)(cosp + (nt - 8) * 16 + fq * 4), s = *(const f32x4*)(sinp + (nt - 8) * 16 + fq * 4);
        const f32x4 x1 = x[nt], x2 = x[nt + 2]; x[nt] = x1 * c - x2 * s; x[nt + 2] = x2 * c + x1 * s; }
#pragma unroll
    for (int nt = 0; nt < 12; ++nt) st4bf(dstrow + nt * 16 + fq * 4, x[nt] * scale);
}

DI void p2_mla(const Params& P, int l, int b, int t0, unsigned char* sm) {
    bf16_t* cqL = (bf16_t*)sm; bf16_t* ckvL = (bf16_t*)(sm + 50176);
    const int tid = tidl(), wid = tid >> 6, lane = tid & 63, fr = lane & 15, fq = lane >> 4; const size_t tokb = (size_t)b * S_ + t0;
#pragma unroll
    for (int i = 0; i < 8; ++i) { const int tl = wid * 8 + i; const bf16_t* up = P.u() + (tokb + tl) * NINP;
        float xq[6], ss = 0.f;
#pragma unroll
        for (int k = 0; k < 6; ++k) { xq[k] = bf2f(up[U_CQ + lane + 64 * k]); ss += xq[k] * xq[k]; }
        ss = wsum(ss); const float rs = rsqrtf(ss * (1.0f / 384.0f) + EPS_);
#pragma unroll
        for (int k = 0; k < 6; ++k) cqL[tl * 392 + lane + 64 * k] = f2bf(xq[k] * rs);
        const float k0 = bf2f(up[U_CKV + lane]), k1 = bf2f(up[U_CKV + lane + 64]);
        const float s2 = wsum(k0 * k0 + k1 * k1), rs2 = rsqrtf(s2 * (1.0f / 128.0f) + EPS_);
        ckvL[tl * 136 + lane] = f2bf(k0 * rs2); ckvL[tl * 136 + lane + 64] = f2bf(k1 * rs2); }
    __syncthreads();
    const int h = wid >> 1, tp = wid & 1;
    const bf16_t* Wq = P.WuqT() + (size_t)l * 768 * 384 + (size_t)(h * 192) * 384;
    const bf16_t* Wkv = P.WukvT() + (size_t)l * 1024 * 128 + (size_t)(h * 256) * 128;
    {
        const int tl0 = (2 * tp) * 16 + fr, tl1 = tl0 + 16; const size_t tok0 = tokb + tl0, tok1 = tokb + tl1;
        {
            f32x4 x0[12], x1[12];
#pragma unroll
            for (int ng = 0; ng < 6; ++ng) { bf16x8 wa[2][12];
#pragma unroll
                for (int q2 = 0; q2 < 2; ++q2) { const bf16_t* wp = launder_p(Wq + (size_t)((2 * ng + q2) * 16 + fr) * 384 + fq * 8);
#pragma unroll
                    for (int ks = 0; ks < 12; ++ks) wa[q2][ks] = *(const bf16x8*)(wp + ks * 32); }
#pragma unroll
                for (int q2 = 0; q2 < 2; ++q2) { f32x4 a0 = fz4(), a1 = fz4();
#pragma unroll
                    for (int ks = 0; ks < 12; ++ks) { a0 = mfma16(wa[q2][ks], *(const bf16x8*)(cqL + tl0 * 392 + ks * 32 + fq * 8), a0); a1 = mfma16(wa[q2][ks], *(const bf16x8*)(cqL + tl1 * 392 + ks * 32 + fq * 8), a1); }
                    x0[2 * ng + q2] = a0; x1[2 * ng + q2] = a1; }
                __builtin_amdgcn_sched_barrier(0); }
            head_norm_rope_store(x0, P.qhg + l * 192, P.cosM() + tok0 * 32, P.sinM() + tok0 * 32, 0.07216878364870322f * LOG2E, P.Qc() + (tok0 * 4 + h) * 192, fq);
            head_norm_rope_store(x1, P.qhg + l * 192, P.cosM() + tok1 * 32, P.sinM() + tok1 * 32, 0.07216878364870322f * LOG2E, P.Qc() + (tok1 * 4 + h) * 192, fq);
        }
        bf16x8 bk0[4], bk1[4];
#pragma unroll
        for (int ks = 0; ks < 4; ++ks) { bk0[ks] = *(const bf16x8*)(ckvL + tl0 * 136 + ks * 32 + fq * 8); bk1[ks] = *(const bf16x8*)(ckvL + tl1 * 136 + ks * 32 + fq * 8); }
        {
            f32x4 x0[12], x1[12];
#pragma unroll
            for (int ng = 0; ng < 2; ++ng) { bf16x8 wa[4][4];
#pragma unroll
                for (int q4 = 0; q4 < 4; ++q4) { const bf16_t* wp = launder_p(Wkv + (size_t)((4 * ng + q4) * 16 + fr) * 128 + fq * 8);
#pragma unroll
                    for (int ks = 0; ks < 4; ++ks) wa[q4][ks] = *(const bf16x8*)(wp + ks * 32); }
#pragma unroll
                for (int q4 = 0; q4 < 4; ++q4) { f32x4 a0 = fz4(), a1 = fz4();
#pragma unroll
                    for (int ks = 0; ks < 4; ++ks) { a0 = mfma16(wa[q4][ks], bk0[ks], a0); a1 = mfma16(wa[q4][ks], bk1[ks], a1); }
                    x0[4 * ng + q4] = a0; x1[4 * ng + q4] = a1; }
                __builtin_amdgcn_sched_barrier(0); }
#pragma unroll
            for (int nt = 8; nt < 12; ++nt) { x0[nt] = ld4bf(P.u() + tok0 * NINP + U_CKR + (nt - 8) * 16 + fq * 4); x1[nt] = ld4bf(P.u() + tok1 * NINP + U_CKR + (nt - 8) * 16 + fq * 4); }
            head_norm_rope_store(x0, P.khg + l * 192, P.cosM() + tok0 * 32, P.sinM() + tok0 * 32, 1.0f, P.Kc() + (((size_t)(b * 4 + h)) * S_ + t0 + tl0) * 192, fq);
            head_norm_rope_store(x1, P.khg + l * 192, P.cosM() + tok1 * 32, P.sinM() + tok1 * 32, 1.0f, P.Kc() + (((size_t)(b * 4 + h)) * S_ + t0 + tl1) * 192, fq);
        }
        {
#pragma unroll
            for (int ng = 0; ng < 2; ++ng) { bf16x8 wa[4][4];
#pragma unroll
                for (int q4 = 0; q4 < 4; ++q4) { const bf16_t* wp = launder_p(Wkv + (size_t)(128 + (4 * ng + q4) * 16 + fr) * 128 + fq * 8);
#pragma unroll
                    for (int ks = 0; ks < 4; ++ks) wa[q4][ks] = *(const bf16x8*)(wp + ks * 32); }
#pragma unroll
                for (int q4 = 0; q4 < 4; ++q4) { f32x4 a0 = fz4(), a1 = fz4();
#pragma unroll
                    for (int ks = 0; ks < 4; ++ks) { a0 = mfma16(wa[q4][ks], bk0[ks], a0); a1 = mfma16(wa[q4][ks], bk1[ks], a1); }
#pragma unroll
                    for (int i = 0; i < 4; ++i) { bf16_t* vp = P.Vct() + ((size_t)b * 512 + h * 128 + (4 * ng + q4) * 16 + fq * 4 + i) * S_ + t0; vp[tl0] = f2bf(a0[i]); vp[tl1] = f2bf(a1[i]); } }
                __builtin_amdgcn_sched_barrier(0); }
        }
    }
    __syncthreads();
}

DI void p2_dil(const Params& P, int l, int b, int t0, unsigned char* sm) {
    bf16_t* vL = (bf16_t*)sm;
    const int tid = tidl(), wid = tid >> 6, lane = tid & 63; const size_t tokb = (size_t)b * S_ + t0;
    u32x4 vpre[8];
#pragma unroll
    for (int i = 0; i < 8; ++i) { const int e = tid + 512 * i, tl = e >> 6, c8 = (e & 63) * 8; vpre[i] = *(const u32x4*)(P.u() + (tokb + tl) * NINP + U_DV + c8); }
    {
        const int c = lane & 15, sub = lane >> 4;
        const f32x4 gq1 = *(const f32x4*)(P.dqg + l * 128 + 4 * c), gq2 = *(const f32x4*)(P.dqg + l * 128 + 64 + 4 * c), gk1 = *(const f32x4*)(P.dkg + l * 128 + 4 * c), gk2 = *(const f32x4*)(P.dkg + l * 128 + 64 + 4 * c);
#pragma unroll 1
        for (int rb = 0; rb < 16; rb += 4) { u32x2 r1[4], r2[4]; f32x4 cs[4], sn[4];
#pragma unroll
            for (int q = 0; q < 4; ++q) { const int row = wid * 64 + (rb + q) * 4 + sub, qk = row & 1, h = (row >> 1) & 3, tl = row >> 3; const size_t tok = tokb + tl;
                const bf16_t* up = P.u() + tok * NINP + (qk ? U_DK : U_DQ) + h * 128; r1[q] = *(const u32x2*)(up + 4 * c); r2[q] = *(const u32x2*)(up + 64 + 4 * c);
                cs[q] = *(const f32x4*)(P.cosD() + tok * 64 + 4 * c); sn[q] = *(const f32x4*)(P.sinD() + tok * 64 + 4 * c); }
#pragma unroll
            for (int q = 0; q < 4; ++q) { const int row = wid * 64 + (rb + q) * 4 + sub, qk = row & 1, h = (row >> 1) & 3, tl = row >> 3; const size_t tok = tokb + tl;
                f32x4 x1, x2; x1[0] = lo2f(r1[q].x); x1[1] = hi2f(r1[q].x); x1[2] = lo2f(r1[q].y); x1[3] = hi2f(r1[q].y); x2[0] = lo2f(r2[q].x); x2[1] = hi2f(r2[q].x); x2[2] = lo2f(r2[q].y); x2[3] = hi2f(r2[q].y);
                float ss = (x1[0] * x1[0] + x1[1] * x1[1]) + (x1[2] * x1[2] + x1[3] * x1[3]) + (x2[0] * x2[0] + x2[1] * x2[1]) + (x2[2] * x2[2] + x2[3] * x2[3]);
                ss += __shfl_xor(ss, 1); ss += __shfl_xor(ss, 2); ss += __shfl_xor(ss, 4); ss += __shfl_xor(ss, 8);
                const float rs = rsqrtf(ss * (1.0f / 128.0f) + EPS_);
                const f32x4 y1 = x1 * rs * (qk ? gk1 : gq1), y2 = x2 * rs * (qk ? gk2 : gq2); const float sc = qk ? 1.0f : 0.08838834764831845f * LOG2E;
                bf16_t* dp = (qk ? P.dk() : P.dq()) + tok * 512 + h * 128; st4bf(dp + 4 * c, (y1 * cs[q] - y2 * sn[q]) * sc); st4bf(dp + 64 + 4 * c, (y2 * cs[q] + y1 * sn[q]) * sc); } }
    }
#pragma unroll
    for (int i = 0; i < 8; ++i) { const int e = tid + 512 * i, tl = e >> 6, c8 = (e & 63) * 8; *(u32x4*)(vL + tl * 520 + c8) = vpre[i]; }
    __syncthreads();
    tr_out(vL, 520, 9, P.Vt1() + (size_t)b * 512 * S_, t0, 1);
    tr_out(vL, 520, 9, P.Vt4() + (size_t)b * 512 * S_, t0, 4);
    tr_out(vL, 520, 9, P.Vt16() + (size_t)b * 512 * S_, t0, 16);
    __syncthreads();
}

DI void phase2(const Params& P, int l, unsigned char* sm) {
    for (int it = blockIdx.x; it < 256; it += gridDim.x) { const int b = it >> 6, t0 = (it & 63) * 64;
#ifdef PROBE_P2
#define P2SPIN(k, call) do { const unsigned long long q0_ = wall_clock64(); call; if (PROBE_P2 == k) { const unsigned long long q1_ = wall_clock64(); while (wall_clock64() - q1_ < q1_ - q0_) __builtin_amdgcn_s_sleep(8); } } while (0)
#else
#define P2SPIN(k, call) call
#endif
        P2SPIN(1, p2_gla(P, l, b, t0, sm)); P2SPIN(2, p2_ssd(P, l, b, t0, sm)); P2SPIN(3, p2_mla(P, l, b, t0, sm)); P2SPIN(4, p2_dil(P, l, b, t0, sm)); }
}

DI void p3_gla_scan(const Params& P, int j) {
    const int tid = tidl(), wid = tid >> 6, lane = tid & 63, fq = lane >> 4; const int bh = j >> 2, b = bh >> 2, h = bh & 3, tix = (j & 3) * 8 + wid, kt = tix >> 3, dvt = tix & 7;
    f32x4 S = fz4();
#pragma unroll 1
    for (int tb = 0; tb < 64; tb += 8) {
        u32x2 lv[8]; f32x4 D[8];
#pragma unroll
        for (int q = 0; q < 8; ++q) { const int t = tb + q; const size_t off = (((((size_t)(b * 64 + t) * 4 + h) * 4 + kt) * 8 + dvt) * 256) + lane * 4;
            lv[q] = *(const u32x2*)(P.Lg() + off);
            D[q] = *(const f32x4*)(P.Dt() + ((size_t)b * 64 + t) * 256 + h * 64 + 16 * kt + 4 * fq); }
#pragma unroll
        for (int q = 0; q < 8; ++q) { const int t = tb + q; const size_t off = (((((size_t)(b * 64 + t) * 4 + h) * 4 + kt) * 8 + dvt) * 256) + lane * 4;
            f32x4 Lv; Lv[0] = lo2f(lv[q].x); Lv[1] = hi2f(lv[q].x); Lv[2] = lo2f(lv[q].y); Lv[3] = hi2f(lv[q].y);
            st4bf(P.Sst() + off, S); S = S * D[q] + Lv; }
    }
}
DI void p3b_gla(const Params& P, int l, int b, int tile, int h, float* oL) {
    const int tid = tidl(), w = tid >> 6, lane = tid & 63, fr = lane & 15, fq = lane >> 4, dv0 = w * 16;
    f32x4 Sa[4];
#pragma unroll
    for (int kt = 0; kt < 4; ++kt) Sa[kt] = ld4bf(P.Sst() + (((((size_t)(b * 64 + tile) * 4 + h) * 4 + kt) * 8 + w) * 256) + lane * 4);
    const bf16_t* Qe = P.Qe() + (size_t)b * S_ * 256 + h * 64;
    const bf16_t* KdT = P.KdT() + ((size_t)b * 256 + h * 64) * S_;
    const bf16_t* vT = P.gvT() + ((size_t)b * 512 + h * 128 + dv0 + fr) * S_;
    const float* dec = P.dec() + (size_t)b * 256 * 256 + h * 64;
    const bf16_t* og = P.ogla() + (size_t)b * S_ * 512 + h * 128 + dv0 + fr;
    bf16x8 qa[4][2], ka[3][4], vb[3]; f32x4 dc[3][4], oi[4];
#pragma unroll
    for (int ch = 0; ch < 4; ++ch) { const int n = tile * 4 + ch, tok0 = 16 * n;
#pragma unroll
        for (int s = 0; s < 2; ++s) qa[ch][s] = ldperm(Qe + (size_t)(tok0 + fr) * 256 + 32 * s, fq);
#pragma unroll
        for (int i = 0; i < 4; ++i) oi[ch][i] = bf2f(og[(size_t)(tok0 + 4 * fq + i) * 512]);
        if (ch < 3) {
#pragma unroll
            for (int kt = 0; kt < 4; ++kt) { ka[ch][kt] = zero8(); if (fq < 2) ka[ch][kt] = *(const bf16x8*)(KdT + (size_t)(16 * kt + fr) * S_ + tok0 + 8 * fq); dc[ch][kt] = *(const f32x4*)(dec + (size_t)n * 256 + 16 * kt + 4 * fq); }
            vb[ch] = zero8(); if (fq < 2) vb[ch] = *(const bf16x8*)(vT + tok0 + 8 * fq); } }
#pragma unroll
    for (int ch = 0; ch < 4; ++ch) {
        f32x4 o = fz4();
#pragma unroll
        for (int s = 0; s < 2; ++s) o = mfma16(qa[ch][s], pack8(Sa[2 * s], Sa[2 * s + 1]), o);
#pragma unroll
        for (int i = 0; i < 4; ++i) oL[(ch * 16 + 4 * fq + i) * 132 + dv0 + fr] = o[i] + oi[ch][i];
        if (ch < 3) {
#pragma unroll
            for (int kt = 0; kt < 4; ++kt) { Sa[kt] = Sa[kt] * dc[ch][kt]; Sa[kt] = mfma16(ka[ch][kt], vb[ch], Sa[kt]); } }
    }
    __syncthreads();
    const size_t tokb = (size_t)b * S_ + tile * 64;
    {
        const int c = lane & 15, sub = lane >> 4;
        const f32x4 g0 = *(const f32x4*)(P.gng + l * 128 + 8 * c), g1 = *(const f32x4*)(P.gng + l * 128 + 8 * c + 4);
        u32x4 gvs[2];
#pragma unroll
        for (int i = 0; i < 2; ++i) gvs[i] = *(const u32x4*)(P.u() + (tokb + w * 8 + i * 4 + sub) * NINP + U_GA + h * 128 + 8 * c);
#pragma unroll
        for (int i = 0; i < 2; ++i) { const int tl = w * 8 + i * 4 + sub;
            const f32x4 x0 = *(const f32x4*)(oL + tl * 132 + 8 * c), x1 = *(const f32x4*)(oL + tl * 132 + 8 * c + 4);
            float ss = (x0[0] * x0[0] + x0[1] * x0[1]) + (x0[2] * x0[2] + x0[3] * x0[3]) + (x1[0] * x1[0] + x1[1] * x1[1]) + (x1[2] * x1[2] + x1[3] * x1[3]);
            ss += __shfl_xor(ss, 1); ss += __shfl_xor(ss, 2); ss += __shfl_xor(ss, 4); ss += __shfl_xor(ss, 8);
            const float rs = rsqrtf(ss * (1.0f / 128.0f) + EPS_);
            const u32x4 gv = gvs[i];
            u32x4 o;
            o.x = pk2(x0[0] * rs * g0[0] * silu_f(lo2f(gv.x)), x0[1] * rs * g0[1] * silu_f(hi2f(gv.x)));
            o.y = pk2(x0[2] * rs * g0[2] * silu_f(lo2f(gv.y)), x0[3] * rs * g0[3] * silu_f(hi2f(gv.y)));
            o.z = pk2(x1[0] * rs * g1[0] * silu_f(lo2f(gv.z)), x1[1] * rs * g1[1] * silu_f(hi2f(gv.z)));
            o.w = pk2(x1[2] * rs * g1[2] * silu_f(lo2f(gv.w)), x1[3] * rs * g1[3] * silu_f(hi2f(gv.w)));
            *(u32x4*)(P.y() + (tokb + tl) * 2048 + h * 128 + 8 * c) = o; }
    }
    __syncthreads();
}
DI void p3_ssd_scan(const Params& P, int j) {
    const int tid = tidl(), wid = tid >> 6, lane = tid & 63; const int bh = j >> 2, b = bh >> 3, h = bh & 7, tix = (j & 3) * 8 + wid;
    f32x4 prev = fz4();
#pragma unroll 1
    for (int cb = 0; cb < 64; cb += 16) {
        u32x2 sv[16]; float al[16];
#pragma unroll
        for (int q = 0; q < 16; ++q) { const size_t bc = (size_t)b * 64 + cb + q; sv[q] = *(const u32x2*)(P.Sg() + ((bc * 8 + h) * 32 + tix) * 256 + lane * 4); al[q] = P.Acs()[(bc * 8 + h) * 64 + 63]; }
#pragma unroll
        for (int q = 0; q < 16; ++q) { const size_t bc = (size_t)b * 64 + cb + q; const size_t off = ((bc * 8 + h) * 32 + tix) * 256 + lane * 4;
            f32x4 s4; s4[0] = lo2f(sv[q].x); s4[1] = hi2f(sv[q].x); s4[2] = lo2f(sv[q].y); s4[3] = hi2f(sv[q].y);
            st4bf(P.Pv() + off, prev); prev = prev * __expf(al[q]) + s4; }
    }
}
DI void ssd_chunk2(const Params& P, int l, int b, int c, int h, int ps0, f32x4 (&yacc)[2][4]) {
    const int lane = tidl() & 63, fr = lane & 15, fq = lane >> 4, g = h >> 2;
    const float Dh = P.sD[l * 8 + h];
    const bf16_t* Bm = P.Bm() + (size_t)b * S_ * 256 + g * 128; const bf16_t* Cm = P.Cm() + (size_t)b * S_ * 256 + g * 128;
    const bf16_t* XdtT = P.XdtT() + ((size_t)b * 512 + h * 64 + ps0 * 16 + fr) * S_;
    const bf16_t* xs = P.xs() + (size_t)b * S_ * 512 + h * 64 + ps0 * 16;
    const int tok0 = 64 * c; const float* acs = P.Acs() + (((size_t)b * 64 + c) * 8 + h) * 64;
    const bf16_t* pv = P.Pv() + (((size_t)(b * 64 + c) * 8 + h) * 32) * 256 + lane * 4;
    float acl[4]; f32x4 acsS[4];
#pragma unroll
    for (int t = 0; t < 4; ++t) { acl[t] = acs[16 * t + fr]; acsS[t] = *(const f32x4*)(acs + 16 * t + 4 * fq); }
    bf16x8 Cp[4][4];
#pragma unroll
    for (int lt = 0; lt < 4; ++lt)
#pragma unroll
        for (int ks = 0; ks < 4; ++ks) Cp[lt][ks] = ldperm(Cm + (size_t)(tok0 + 16 * lt + fr) * 256 + 32 * ks, fq);
    bf16x8 pa[2][4];
#pragma unroll
    for (int p = 0; p < 2; ++p)
#pragma unroll
        for (int ks = 0; ks < 4; ++ks) pa[p][ks] = cat4(*(const s16x4*)(pv + ((2 * ks) * 4 + ps0 + p) * 256), *(const s16x4*)(pv + ((2 * ks + 1) * 4 + ps0 + p) * 256));
    f32x4 xv[2][4];
#pragma unroll
    for (int p = 0; p < 2; ++p)
#pragma unroll
        for (int lt = 0; lt < 4; ++lt) xv[p][lt] = ld4bf(xs + (size_t)(tok0 + 16 * lt + fr) * 512 + 16 * p + 4 * fq);
#pragma unroll
    for (int lt = 0; lt < 4; ++lt) { const float el = __expf(acl[lt]);
#pragma unroll
        for (int p = 0; p < 2; ++p) { f32x4 yo = fz4();
#pragma unroll
            for (int ks = 0; ks < 4; ++ks) yo = mfma16(pa[p][ks], Cp[lt][ks], yo);
            yacc[p][lt] = yo * el + xv[p][lt] * Dh; } }
#pragma unroll
    for (int ks2 = 0; ks2 < 2; ++ks2) {
        bf16x8 Bp0[4], Bp1[4];
#pragma unroll
        for (int ks = 0; ks < 4; ++ks) { Bp0[ks] = ldperm(Bm + (size_t)(tok0 + 32 * ks2 + fr) * 256 + 32 * ks, fq); Bp1[ks] = ldperm(Bm + (size_t)(tok0 + 32 * ks2 + 16 + fr) * 256 + 32 * ks, fq); }
        const bf16x8 xa0 = ldperm(XdtT + tok0 + 32 * ks2, fq), xa1 = ldperm(XdtT + (size_t)16 * S_ + tok0 + 32 * ks2, fq);
#pragma unroll
        for (int lt = 2 * ks2; lt < 4; ++lt) {
            f32x4 g0 = fz4(), g1 = fz4();
#pragma unroll
            for (int ks = 0; ks < 4; ++ks) { g0 = mfma16(Bp0[ks], Cp[lt][ks], g0); g1 = mfma16(Bp1[ks], Cp[lt][ks], g1); }
            const int lpos = 16 * lt + fr;
#pragma unroll
            for (int i = 0; i < 4; ++i) { const int s0 = 32 * ks2 + 4 * fq + i, s1 = s0 + 16;
                const float e0 = __expf(acl[lt] - acsS[2 * ks2][i]), e1 = __expf(acl[lt] - acsS[2 * ks2 + 1][i]);
                g0[i] = (s0 <= lpos) ? g0[i] * e0 : 0.f; g1[i] = (s1 <= lpos) ? g1[i] * e1 : 0.f; }
            const bf16x8 pk = pack8(g0, g1);
            yacc[0][lt] = mfma16(xa0, pk, yacc[0][lt]); yacc[1][lt] = mfma16(xa1, pk, yacc[1][lt]);
        }
    }
}

DI void ssd_chunk3(const Params& P, int l, int b, int c, int h, int ps0, const bf16_t* CL, const float* GT, f32x4 (&yacc)[2][4]) {
    const int lane = tidl() & 63, fr = lane & 15, fq = lane >> 4;
    const float Dh = P.sD[l * 8 + h];
    const bf16_t* XdtT = P.XdtT() + ((size_t)b * 512 + h * 64 + ps0 * 16 + fr) * S_;
    const bf16_t* xs = P.xs() + (size_t)b * S_ * 512 + h * 64 + ps0 * 16;
    const int tok0 = 64 * c; const float* acs = P.Acs() + (((size_t)b * 64 + c) * 8 + h) * 64;
    const bf16_t* pv = P.Pv() + (((size_t)(b * 64 + c) * 8 + h) * 32) * 256 + lane * 4;
    float acl[4]; f32x4 acsS[4];
#pragma unroll
    for (int t = 0; t < 4; ++t) { acl[t] = acs[16 * t + fr]; acsS[t] = *(const f32x4*)(acs + 16 * t + 4 * fq); }
    bf16x8 pa[2][4];
#pragma unroll
    for (int p = 0; p < 2; ++p)
#pragma unroll
        for (int ks = 0; ks < 4; ++ks) pa[p][ks] = cat4(*(const s16x4*)(pv + ((2 * ks) * 4 + ps0 + p) * 256), *(const s16x4*)(pv + ((2 * ks + 1) * 4 + ps0 + p) * 256));
    f32x4 xv[2][4];
#pragma unroll
    for (int p = 0; p < 2; ++p)
#pragma unroll
        for (int lt = 0; lt < 4; ++lt) xv[p][lt] = ld4bf(xs + (size_t)(tok0 + 16 * lt + fr) * 512 + 16 * p + 4 * fq);
    bf16x8 xa[2][2];
#pragma unroll
    for (int ks2 = 0; ks2 < 2; ++ks2) { xa[0][ks2] = ldperm(XdtT + tok0 + 32 * ks2, fq); xa[1][ks2] = ldperm(XdtT + (size_t)16 * S_ + tok0 + 32 * ks2, fq); }
#pragma unroll
    for (int lt = 0; lt < 4; ++lt) { const float el = __expf(acl[lt]); f32x4 yo0 = fz4(), yo1 = fz4();
#pragma unroll
        for (int ks = 0; ks < 4; ++ks) { const bf16x8 cp = ldperm(CL + (16 * lt + fr) * 136 + 32 * ks, fq); yo0 = mfma16(pa[0][ks], cp, yo0); yo1 = mfma16(pa[1][ks], cp, yo1); }
        yacc[0][lt] = yo0 * el + xv[0][lt] * Dh; yacc[1][lt] = yo1 * el + xv[1][lt] * Dh; }
#pragma unroll
    for (int ks2 = 0; ks2 < 2; ++ks2)
#pragma unroll
        for (int lt = 2 * ks2; lt < 4; ++lt) {
            f32x4 g0 = *(const f32x4*)(GT + ((2 * ks2) * 4 + lt) * 256 + lane * 4), g1 = (2 * ks2 + 1 <= lt) ? *(const f32x4*)(GT + ((2 * ks2 + 1) * 4 + lt) * 256 + lane * 4) : fz4();
            const int lpos = 16 * lt + fr;
#pragma unroll
            for (int i = 0; i < 4; ++i) { const int s0 = 32 * ks2 + 4 * fq + i, s1 = s0 + 16;
                const float e0 = __expf(acl[lt] - acsS[2 * ks2][i]), e1 = __expf(acl[lt] - acsS[2 * ks2 + 1][i]);
                g0[i] = (s0 <= lpos) ? g0[i] * e0 : 0.f; g1[i] = (s1 <= lpos) ? g1[i] * e1 : 0.f; }
            const bf16x8 pk = pack8(g0, g1);
            yacc[0][lt] = mfma16(xa[0][ks2], pk, yacc[0][lt]); yacc[1][lt] = mfma16(xa[1][ks2], pk, yacc[1][lt]);
        }
}

DI void p3_mla(const Params& P, int b, int h, int qb, unsigned char* sm) {
    bf16_t* KL = (bf16_t*)sm; bf16_t* VL = (bf16_t*)(sm + 25600);
    const int tid = tidl(), wid = tid >> 6, lane = tid & 63, fr = lane & 15, fq = lane >> 4;
    const int qbase = qb * 256 + wid * 32;
    bf16x8 Qf[2][6];
#pragma unroll
    for (int qt = 0; qt < 2; ++qt)
#pragma unroll
        for (int ks = 0; ks < 6; ++ks) Qf[qt][ks] = *(const bf16x8*)(P.Qc() + (((size_t)b * S_ + qbase + qt * 16 + fr) * 4 + h) * 192 + ks * 32 + fq * 8);
    f32x4 oacc[2][8];
#pragma unroll
    for (int i = 0; i < 8; ++i) { oacc[0][i] = fz4(); oacc[1][i] = fz4(); }
    float m[2] = {-1e30f, -1e30f}, lsum[2] = {0.f, 0.f};
    const bf16_t* Kg = P.Kc() + ((size_t)(b * 4 + h)) * S_ * 192; const bf16_t* Vg = P.Vct() + ((size_t)b * 512 + h * 128) * S_;
    const int nkt = 4 * qb + 4;
    u32x4 kr[3], vr[2];
#define MLA_GLOAD(kt) do { _Pragma("unroll") for (int i = 0; i < 3; ++i) { const int e = tid + 512 * i, row = e / 24, c16 = e % 24; kr[i] = *(const u32x4*)(Kg + (size_t)((kt) * 64 + row) * 192 + c16 * 8); } \
                           _Pragma("unroll") for (int i = 0; i < 2; ++i) { const int e = tid + 512 * i, row = e >> 3, c16 = e & 7; vr[i] = *(const u32x4*)(Vg + (size_t)row * S_ + (kt) * 64 + c16 * 8); } } while (0)
    MLA_GLOAD(0);
#pragma unroll 1
    for (int kt = 0; kt < nkt; ++kt) {
        __syncthreads();
#pragma unroll
        for (int i = 0; i < 3; ++i) { const int e = tid + 512 * i, row = e / 24, c16 = e % 24; *(u32x4*)(KL + row * 200 + c16 * 8) = kr[i]; }
#pragma unroll
        for (int i = 0; i < 2; ++i) { const int e = tid + 512 * i, row = e >> 3, c16 = e & 7; *(u32x4*)(VL + row * 72 + c16 * 8) = vr[i]; }
        __syncthreads();
        if (kt + 1 < nkt) MLA_GLOAD(kt + 1);
        if (kt * 64 <= qbase + 31) {
            f32x4 s[2][4]; bf16x8 ka[2][6];
#pragma unroll
            for (int j = 0; j < 4; ++j) { s[0][j] = fz4(); s[1][j] = fz4();
                if (j == 0) {
#pragma unroll
                    for (int ks = 0; ks < 6; ++ks) ka[0][ks] = *(const bf16x8*)(KL + fr * 200 + ks * 32 + fq * 8); }
                if (j < 3) {
#pragma unroll
                    for (int ks = 0; ks < 6; ++ks) ka[(j + 1) & 1][ks] = *(const bf16x8*)(KL + ((j + 1) * 16 + fr) * 200 + ks * 32 + fq * 8); }
                __builtin_amdgcn_sched_barrier(0);
#pragma unroll
                for (int ks = 0; ks < 6; ++ks) { const bf16x8 a = ka[j & 1][ks]; s[0][j] = mfma16(a, Qf[0][ks], s[0][j]); s[1][j] = mfma16(a, Qf[1][ks], s[1][j]); }
                __builtin_amdgcn_sched_barrier(0); }
            bf16x8 pb[2][2];
#pragma unroll
            for (int qt = 0; qt < 2; ++qt) { const int qrow = qbase + qt * 16 + fr;
                if (kt >= 4 * qb) {
#pragma unroll
                    for (int j = 0; j < 4; ++j)
#pragma unroll
                        for (int i = 0; i < 4; ++i) { const int key = kt * 64 + j * 16 + fq * 4 + i; if (key > qrow) s[qt][j][i] = -1e30f; } }
                float mx = -1e30f;
#pragma unroll
                for (int j = 0; j < 4; ++j) mx = fmaxf(mx, fmaxf(fmaxf(s[qt][j][0], s[qt][j][1]), fmaxf(s[qt][j][2], s[qt][j][3])));
                mx = fmaxf(mx, __shfl_xor(mx, 16)); mx = fmaxf(mx, __shfl_xor(mx, 32));
                const float mn = fmaxf(m[qt], mx), alpha = __builtin_amdgcn_exp2f(m[qt] - mn); m[qt] = mn;
                float psum = 0.f;
#pragma unroll
                for (int j = 0; j < 4; ++j)
#pragma unroll
                    for (int i = 0; i < 4; ++i) { s[qt][j][i] = __builtin_amdgcn_exp2f(s[qt][j][i] - mn); psum += s[qt][j][i]; }
                lsum[qt] = lsum[qt] * alpha + psum;
                if (__builtin_amdgcn_ballot_w64(alpha != 1.0f) != 0ull) {
#pragma unroll
                    for (int dt = 0; dt < 8; ++dt) oacc[qt][dt] = oacc[qt][dt] * alpha; }
                pb[qt][0] = pack8(s[qt][0], s[qt][1]); pb[qt][1] = pack8(s[qt][2], s[qt][3]); }
#pragma unroll
            for (int kk = 0; kk < 2; ++kk) { bf16x8 va[8];
#pragma unroll
                for (int dt = 0; dt < 8; ++dt) va[dt] = ldperm(VL + (dt * 16 + fr) * 72 + kk * 32, fq);
                __builtin_amdgcn_sched_barrier(0);
#pragma unroll
                for (int dt = 0; dt < 8; ++dt) { const bf16x8 a = va[dt]; oacc[0][dt] = mfma16(a, pb[0][kk], oacc[0][dt]); oacc[1][dt] = mfma16(a, pb[1][kk], oacc[1][dt]); } }
        }
    }
#undef MLA_GLOAD
#pragma unroll
    for (int qt = 0; qt < 2; ++qt) { float ls = lsum[qt]; ls += __shfl_xor(ls, 16); ls += __shfl_xor(ls, 32); const float inv = 1.0f / ls;
        const size_t tokq = (size_t)b * S_ + qbase + qt * 16 + fr;
        f32x4 gvv[8];
#pragma unroll
        for (int dt = 0; dt < 8; ++dt) gvv[dt] = ld4bf(P.u() + tokq * NINP + U_GC + h * 128 + dt * 16 + fq * 4);
#pragma unroll
        for (int dt = 0; dt < 8; ++dt) { const f32x4 gv = gvv[dt]; f32x4 o = oacc[qt][dt] * inv;
            o[0] *= silu_f(gv[0]); o[1] *= silu_f(gv[1]); o[2] *= silu_f(gv[2]); o[3] *= silu_f(gv[3]);
            st4bf(P.y() + tokq * 2048 + 1024 + h * 128 + dt * 16 + fq * 4, o); } }
}

struct DilItem { int cfg, b, h, d, Pn, rd, P0; };
DI DilItem dil_decode(int j) { DilItem t; t.cfg = j >> 9; const int jj = j & 511, bh = jj >> 5, q = jj & 31; t.b = bh >> 2; t.h = bh & 3;
    t.d = t.cfg == 0 ? 1 : (t.cfg == 1 ? 4 : 16); t.Pn = S_ / t.d;
    t.rd = t.cfg == 0 ? 0 : (t.cfg == 1 ? (q >> 3) : (q >> 1)); t.P0 = (t.cfg == 0 ? q : (t.cfg == 1 ? (q & 7) : (q & 1))) * 128; return t; }
DI void p3_dil2(const Params& P, int l, int j, unsigned char* sm, int* s_item) {
    bf16_t* KL = (bf16_t*)sm; bf16_t* VL = (bf16_t*)sm;
    const int tid = tidl(), w = tid >> 6, lane = tid & 63, fr = lane & 15, fq = lane >> 4;
    const float mgq = wmaxf(fmaxf(fabsf(P.dqg[l * 128 + lane]), fabsf(P.dqg[l * 128 + 64 + lane]))), mgk = wmaxf(fmaxf(fabsf(P.dkg[l * 128 + lane]), fabsf(P.dkg[l * 128 + 64 + lane])));
    const float Mb = 11.313708498984761f * LOG2E * mgq * mgk;
    u32x4 rg[8], rv[8];
#define DIL_KLOAD(T) do { const bf16_t* dkb_ = P.dk() + (size_t)(T).b * S_ * 512 + (T).h * 128; \
        _Pragma("unroll") for (int i = 0; i < 8; ++i) { const int u = tid + 512 * i, row = u >> 4, c16 = u & 15, kp = (T).P0 - 128 + row; \
            rg[i] = (u32x4){0u, 0u, 0u, 0u}; if (kp >= 0) rg[i] = *(const u32x4*)(dkb_ + (size_t)(kp * (T).d + (T).rd) * 512 + c16 * 8); } } while (0)
    DilItem t = dil_decode(j);
    DIL_KLOAD(t);
    for (;;) {
        const bf16_t* vtb = (t.cfg == 0 ? P.Vt1() : (t.cfg == 1 ? P.Vt4() : P.Vt16())) + ((size_t)t.b * 512 + t.h * 128) * S_; const int run = 64 / t.d, rlog = t.cfg == 0 ? 6 : (t.cfg == 1 ? 4 : 2);
        const int pq = t.P0 + 16 * w + fr; const size_t tokq = (size_t)t.b * S_ + pq * t.d + t.rd;
        bf16x8 Qf[4];
#pragma unroll
        for (int ks = 0; ks < 4; ++ks) Qf[ks] = *(const bf16x8*)(P.dq() + tokq * 512 + t.h * 128 + 32 * ks + 8 * fq);
#pragma unroll
        for (int i = 0; i < 8; ++i) { const int u = tid + 512 * i, row = u >> 4, c16 = u & 15; *(u32x4*)(KL + row * 136 + c16 * 8) = rg[i]; }
        __syncthreads();
        if (tid == 0) *s_item = (int)atomicAdd(P.ctr() + l, 1u);
#pragma unroll
        for (int i = 0; i < 8; ++i) { const int u = tid + 512 * i, row = u >> 5, c16 = u & 31, kp = t.P0 - 128 + c16 * 8;
            rv[i] = (u32x4){0u, 0u, 0u, 0u};
            if (kp >= 0) { const int k1 = kp + 4;
                const u32x2 lo = *(const u32x2*)(vtb + (size_t)row * S_ + ((kp >> rlog) << 6) + t.rd * run + (kp & (run - 1))), hi = *(const u32x2*)(vtb + (size_t)row * S_ + ((k1 >> rlog) << 6) + t.rd * run + (k1 & (run - 1)));
                rv[i] = (u32x4){lo.x, lo.y, hi.x, hi.y}; } }
        bf16x8 pb[5]; float lsum = 0.f;
#pragma unroll
        for (int kk = 0; kk < 5; ++kk) { f32x4 s0 = fz4(), s1 = fz4();
            const int r0 = min(16 * w + 32 * kk + fr, 255), r1 = min(16 * w + 32 * kk + 16 + fr, 255);
            bf16x8 ka0[4], ka1[4];
#pragma unroll
            for (int ks = 0; ks < 4; ++ks) { ka0[ks] = *(const bf16x8*)(KL + r0 * 136 + 32 * ks + 8 * fq); ka1[ks] = *(const bf16x8*)(KL + r1 * 136 + 32 * ks + 8 * fq); }
            __builtin_amdgcn_sched_barrier(0);
#pragma unroll
            for (int ks = 0; ks < 4; ++ks) { s0 = mfma16(ka0[ks], Qf[ks], s0); s1 = mfma16(ka1[ks], Qf[ks], s1); }
#pragma unroll
            for (int i = 0; i < 4; ++i) { const int rk = 16 * w + 32 * kk + 4 * fq + i, df = 128 + fr - 32 * kk - 4 * fq - i;
                const bool v0 = (df >= 0) && (df <= 128) && (t.P0 - 128 + rk >= 0), v1 = (df - 16 >= 0) && (df - 16 <= 128) && (t.P0 - 128 + rk + 16 >= 0);
                s0[i] = v0 ? __builtin_amdgcn_exp2f(s0[i] - Mb) : 0.f; s1[i] = v1 ? __builtin_amdgcn_exp2f(s1[i] - Mb) : 0.f; lsum += s0[i] + s1[i]; }
            pb[kk] = pack8(s0, s1); }
        __syncthreads();
        const int jn = *s_item - 448; const bool more = jn < 1536;
#pragma unroll
        for (int i = 0; i < 8; ++i) { const int u = tid + 512 * i, row = u >> 5, c16 = u & 31; *(u32x4*)(VL + row * 264 + c16 * 8) = rv[i]; }
        __syncthreads();
        DilItem tn = dil_decode(more ? jn : 0);
        if (more) DIL_KLOAD(tn);
        f32x4 oacc[8];
#pragma unroll
        for (int i = 0; i < 8; ++i) oacc[i] = fz4();
#pragma unroll
        for (int kk = 0; kk < 5; ++kk) { const int c0 = min(16 * w + 32 * kk + 4 * fq, 252), c1 = min(16 * w + 32 * kk + 16 + 4 * fq, 252);
            bf16x8 va[8];
#pragma unroll
            for (int dt = 0; dt < 8; ++dt) va[dt] = cat4(*(const s16x4*)(VL + (16 * dt + fr) * 264 + c0), *(const s16x4*)(VL + (16 * dt + fr) * 264 + c1));
            __builtin_amdgcn_sched_barrier(0);
#pragma unroll
            for (int dt = 0; dt < 8; ++dt) oacc[dt] = mfma16(va[dt], pb[kk], oacc[dt]); }
        lsum += __shfl_xor(lsum, 16); lsum += __shfl_xor(lsum, 32);
        bf16_t* op = t.cfg == 0 ? P.y() + tokq * 2048 + 1536 + t.h * 128 : (t.cfg == 1 ? P.Od4() : P.Od16()) + tokq * 512 + t.h * 128;
#pragma unroll
        for (int dt = 0; dt < 8; ++dt) st4bf(op + 16 * dt + 4 * fq, oacc[dt]);
        if (fq == 0) P.ldp()[((size_t)t.cfg * T_ + tokq) * 4 + t.h] = lsum;
        __syncthreads();
        if (!more) break;
        t = tn;
    }
#undef DIL_KLOAD
}

DI void phase3(const Params& P, int l, unsigned char* sm, int* s_item) {
    const int tid = tidl(), wid = tid >> 6;
#ifndef P3_DYNAMIC
#define P3_DYNAMIC 1
#endif
    for (int it_ = blockIdx.x;; it_ += gridDim.x) {
        __syncthreads();
#if P3_DYNAMIC
        if (tid == 0) *s_item = (int)atomicAdd(P.ctr() + l, 1u);
        __syncthreads();
        const int idx = *s_item;
#else
        const int idx = it_;
#endif
        if (idx >= P3_NITEMS) break;
#ifndef ONLY_P3
#define ONLY_P3 -1
#endif
#ifdef PROBE_ITEM
        const unsigned long long it0 = wall_clock64();
#endif
        if (idx < 256) { const int bh = idx & 15; if (ONLY_P3 < 0 || ONLY_P3 == 3) p3_mla(P, bh >> 2, bh & 3, 15 - (idx >> 4), sm); }
        else if (idx < 320) { if (ONLY_P3 < 0 || ONLY_P3 == 1) p3_gla_scan(P, idx - 256); }
        else if (idx < 448) { if (ONLY_P3 < 0 || ONLY_P3 == 2) p3_ssd_scan(P, idx - 320); }
        else { if (ONLY_P3 < 0 || ONLY_P3 == 4) p3_dil2(P, l, idx - 448, sm, s_item); }
#ifdef PROBE_ITEM
        { const int cls = idx < 256 ? 3 : (idx < 320 ? 1 : (idx < 448 ? 2 : 4)); if (cls == PROBE_ITEM) { const unsigned long long it1 = wall_clock64(); while (wall_clock64() - it1 < it1 - it0) __builtin_amdgcn_s_sleep(8); } }
#endif
    }
}

DI void phase3b(const Params& P, int l, unsigned char* sm) {
    const int tid = tidl(), wid = tid >> 6, lane = tid & 63, fr = lane & 15, fq = lane >> 4;
    for (int rowb = blockIdx.x * 8 + wid; rowb < T_; rowb += gridDim.x * 8 * 8) { const int hh = lane >> 4, c = lane * 8;
        u32x4 a0[8], a1[8], a2[8], gv[8]; float inv[8];
#pragma unroll
        for (int q = 0; q < 8; ++q) { const int row = rowb + q * gridDim.x * 8; if (row < T_) {
            a0[q] = *(const u32x4*)(P.y() + (size_t)row * 2048 + 1536 + c); a1[q] = *(const u32x4*)(P.Od4() + (size_t)row * 512 + c); a2[q] = *(const u32x4*)(P.Od16() + (size_t)row * 512 + c); gv[q] = *(const u32x4*)(P.u() + (size_t)row * NINP + U_GD + c);
            inv[q] = P.ldp()[(size_t)row * 4 + hh] + P.ldp()[((size_t)T_ + row) * 4 + hh] + P.ldp()[((size_t)2 * T_ + row) * 4 + hh]; } }
#pragma unroll
        for (int q = 0; q < 8; ++q) { const int row = rowb + q * gridDim.x * 8; if (row < T_) { const float iv = 1.0f / inv[q]; u32x4 o;
            o.x = pk2((lo2f(a0[q].x) + lo2f(a1[q].x) + lo2f(a2[q].x)) * iv * silu_f(lo2f(gv[q].x)), (hi2f(a0[q].x) + hi2f(a1[q].x) + hi2f(a2[q].x)) * iv * silu_f(hi2f(gv[q].x)));
            o.y = pk2((lo2f(a0[q].y) + lo2f(a1[q].y) + lo2f(a2[q].y)) * iv * silu_f(lo2f(gv[q].y)), (hi2f(a0[q].y) + hi2f(a1[q].y) + hi2f(a2[q].y)) * iv * silu_f(hi2f(gv[q].y)));
            o.z = pk2((lo2f(a0[q].z) + lo2f(a1[q].z) + lo2f(a2[q].z)) * iv * silu_f(lo2f(gv[q].z)), (hi2f(a0[q].z) + hi2f(a1[q].z) + hi2f(a2[q].z)) * iv * silu_f(hi2f(gv[q].z)));
            o.w = pk2((lo2f(a0[q].w) + lo2f(a1[q].w) + lo2f(a2[q].w)) * iv * silu_f(lo2f(gv[q].w)), (hi2f(a0[q].w) + hi2f(a1[q].w) + hi2f(a2[q].w)) * iv * silu_f(hi2f(gv[q].w)));
            *(u32x4*)(P.y() + (size_t)row * 2048 + 1536 + c) = o; } }
    }
    for (int it = blockIdx.x; it < 1024; it += gridDim.x) p3b_gla(P, l, it >> 8, (it >> 2) & 63, it & 3, (float*)sm);
    float* yL = (float*)sm;
    bf16_t* CL = (bf16_t*)(sm + 66560); bf16_t* BL = (bf16_t*)(sm + 66560 + 17408); float* GT = (float*)(sm + 66560 + 2 * 17408);
    for (int it = blockIdx.x; it < 512; it += gridDim.x) { const int g = it & 1, c = (it >> 1) & 63, b = it >> 7; const size_t tokb = (size_t)b * S_ + 64 * c;
        const int h = g * 4 + (wid >> 1);
#pragma unroll
        for (int i = 0; i < 4; ++i) { const int u = tid + 512 * i, sel = u >> 10, row = (u >> 4) & 63, c16 = u & 15;
            const u32x4 v = *(const u32x4*)((sel ? P.Bm() : P.Cm()) + (tokb + row) * 256 + g * 128 + c16 * 8); *(u32x4*)((sel ? BL : CL) + row * 136 + c16 * 8) = v; }
        __syncthreads();
#pragma unroll 1
        for (int tix = wid; tix < 10; tix += 8) {
            const int st = tix < 4 ? 0 : (tix < 7 ? 1 : (tix < 9 ? 2 : 3)), lt = tix < 4 ? tix : (tix < 7 ? tix - 3 : (tix < 9 ? tix - 5 : 3));
            f32x4 gacc = fz4();
#pragma unroll
            for (int ks = 0; ks < 4; ++ks) gacc = mfma16(*(const bf16x8*)(BL + (16 * st + fr) * 136 + 32 * ks + 8 * fq), *(const bf16x8*)(CL + (16 * lt + fr) * 136 + 32 * ks + 8 * fq), gacc);
            *(f32x4*)(GT + (st * 4 + lt) * 256 + lane * 4) = gacc; }
        __syncthreads();
        { const int ps0 = (wid & 1) * 2; f32x4 yacc[2][4];
            u32x2 zr[2][4];
#pragma unroll
            for (int p = 0; p < 2; ++p)
#pragma unroll
                for (int lt = 0; lt < 4; ++lt) zr[p][lt] = *(const u32x2*)(P.u() + (tokb + 16 * lt + fr) * NINP + U_GB + g * 256 + (h & 3) * 64 + (ps0 + p) * 16 + 4 * fq);
            ssd_chunk3(P, l, b, c, h, ps0, CL, GT, yacc);
#pragma unroll
            for (int p = 0; p < 2; ++p)
#pragma unroll
                for (int lt = 0; lt < 4; ++lt) { const int tl = 16 * lt + fr, col = (h & 3) * 64 + (ps0 + p) * 16 + 4 * fq;
                    f32x4 z; z[0] = lo2f(zr[p][lt].x); z[1] = hi2f(zr[p][lt].x); z[2] = lo2f(zr[p][lt].y); z[3] = hi2f(zr[p][lt].y); f32x4 v = yacc[p][lt];
                    v[0] *= silu_f(z[0]); v[1] *= silu_f(z[1]); v[2] *= silu_f(z[2]); v[3] *= silu_f(z[3]);
                    *(f32x4*)(yL + tl * 260 + col) = v; } }
        __syncthreads();
        const f32x4 gn = *(const f32x4*)(P.sng + l * 512 + g * 256 + lane * 4);
#pragma unroll 4
        for (int i = 0; i < 8; ++i) { const int tl = wid * 8 + i; const f32x4 v = *(const f32x4*)(yL + tl * 260 + lane * 4);
            const float rs = rsqrtf(wsum(v[0] * v[0] + v[1] * v[1] + v[2] * v[2] + v[3] * v[3]) * (1.0f / 256.0f) + EPS_);
            st4bf(P.y() + (tokb + tl) * 2048 + 512 + g * 256 + lane * 4, v * rs * gn); }
        __syncthreads();
    }
}


DI void phase_rstd(const Params& P) {
    const int tid = tidl();
    for (int row = blockIdx.x * 64 + (tid >> 3); row < T_; row += gridDim.x * 64) {
        const f32x4 v = *(const f32x4*)(P.rowsq() + (size_t)row * 32 + (tid & 7) * 4); float sq = (v[0] + v[1]) + (v[2] + v[3]);
        sq += __shfl_xor(sq, 1); sq += __shfl_xor(sq, 2); sq += __shfl_xor(sq, 4);
        if ((tid & 7) == 0) P.rstd()[row] = rsqrtf(sq * (1.0f / 2048.0f) + EPS_); }
}

#define XB_TMO      128
#define XB_XCNT(j)  (256  + 64 * (j))
#define XB_XSUB(j)  (1280 + 64 * (j))
#define XB_XGEN(j)  (2304 + 64 * (j))
#define XB_TOP      3328
#define XB_TOPGEN   3392
#define XCD_BAR_WORDS 3456
#define XB_SPIN_CAP (1u << 18)
#define XB_LAS __attribute__((address_space(3)))
DI unsigned xb_ld(unsigned* p)              { return __hip_atomic_load(p, __ATOMIC_RELAXED, __HIP_MEMORY_SCOPE_AGENT); }
DI unsigned xb_add(unsigned* p, unsigned v) { return __hip_atomic_fetch_add(p, v, __ATOMIC_RELAXED, __HIP_MEMORY_SCOPE_AGENT); }
DI unsigned xb_xcc_id() { return (unsigned)__builtin_amdgcn_s_getreg((3 << 11) | 20) & 0xFu; }
#define XB_SPIN(cond, bar) do { unsigned _sp = 0; while (cond) { __builtin_amdgcn_s_sleep(1); \
    if ((++_sp & 255u) == 0u) { if (xb_ld(&(bar)[XB_TMO])) break; if (_sp > XB_SPIN_CAP) { atomicAdd(&(bar)[XB_TMO], 1u); break; } } } } while (0)
DI void xcd_barrier_post(unsigned* bar) { if (threadIdx.x == 0) (void)xb_add(&bar[XB_XCNT(xb_xcc_id())], 1u); }
DI void xcd_barrier_complete(unsigned* bar, unsigned x, unsigned& nloc, unsigned& nx) {
    const unsigned G = gridDim.x * gridDim.y * gridDim.z;
    unsigned sum, cnt, mine, sp = 0u;
    for (;;) {
        sum = 0u; cnt = 0u; mine = 0u;
#pragma unroll
        for (unsigned j = 0; j < 16; ++j) { const unsigned c = xb_ld(&bar[XB_XCNT(j)]); sum += c; cnt += (c > 0u) ? 1u : 0u; mine = (j == x) ? c : mine; }
        if (sum == G) break;
        __builtin_amdgcn_s_sleep(1);
        if ((++sp & 255u) == 0u) { if (xb_ld(&bar[XB_TMO])) break; if (sp > XB_SPIN_CAP) { atomicAdd(&bar[XB_TMO], 1u); break; } }
    }
    nloc = mine > 0u ? mine : 1u; nx = cnt > 0u ? cnt : 1u;
}
DI void xcd_barrier(unsigned* bar, volatile XB_LAS unsigned* st) {
    asm volatile("s_waitcnt vmcnt(0)" ::: "memory");
    __syncthreads();
    if (threadIdx.x == 0) {
        const unsigned x = xb_xcc_id();
        __builtin_amdgcn_s_waitcnt(0);
        unsigned nloc = st[0], nx = st[1];
        if (nloc == 0u) { xcd_barrier_complete(bar, x, nloc, nx); st[0] = nloc; st[1] = nx; }
        const unsigned old = xb_add(&bar[XB_XSUB(x)], 1u);
        const unsigned gen = old / nloc;
        if (old + 1u == (gen + 1u) * nloc) {
            __builtin_amdgcn_fence(__ATOMIC_RELEASE, "agent");
            asm volatile("s_waitcnt vmcnt(0)" ::: "memory");
            const unsigned og = xb_add(&bar[XB_TOP], 1u);
            const unsigned tg = og / nx;
            if (og + 1u == (tg + 1u) * nx) xb_add(&bar[XB_TOPGEN], 1u);
            else XB_SPIN(xb_ld(&bar[XB_TOPGEN]) == tg, bar);
            __builtin_amdgcn_fence(__ATOMIC_ACQUIRE, "agent");
            xb_add(&bar[XB_XGEN(x)], 1u);
            asm volatile("s_waitcnt vmcnt(0)" ::: "memory");
        } else {
            XB_SPIN(xb_ld(&bar[XB_XGEN(x)]) == gen, bar);
            __builtin_amdgcn_fence(__ATOMIC_ACQUIRE, "agent");
            asm volatile("s_waitcnt vmcnt(0)" ::: "memory");
        }
    }
    __syncthreads();
}

extern __shared__ __attribute__((aligned(16))) unsigned char smem[];
__global__ __launch_bounds__(512, 2) void mk_fwd(Params Pk) {
    __shared__ int s_item;
    __shared__ uint4 xb_words;
#ifndef ONLY_S
#define ONLY_S -1
#endif
    if (Pk.ph_hi > Pk.ph_lo) { if (threadIdx.x == 0) xb_words = make_uint4(0u, 0u, 0u, 0u); __syncthreads(); xcd_barrier_post(Pk.bar()); }
    for (int phi = Pk.ph_lo; phi <= Pk.ph_hi; ++phi) {
        if (Pk.ph_lo < -1000) cg::this_grid().sync();
        if (phi > Pk.ph_lo) xcd_barrier(Pk.bar(), (volatile XB_LAS unsigned*)&xb_words);
        Params P = Pk; int ph = phi; size_t z0 = 0, z1 = 0;
        asm volatile("" : "+s"(z0), "+s"(z1), "+s"(ph));
        P.ws = Pk.ws + z0; P.out = Pk.out + z1;
        if (ph == 0) { if (ONLY_S < 0 || ONLY_S == 9) phase0(P, smem); continue; }
        const int l = (ph - 1) / 6, s = (ph - 1) % 6;
#ifdef PROBE_S
        const unsigned long long pt0 = wall_clock64();
#endif
        if (s == 0) { if (ONLY_S < 0 || ONLY_S == 0) {
            pg8::Gemm g; g.A = P.xb(); g.Bt = P.WinT() + (size_t)l * NINP * 2048; g.M = T_; g.N = NINP; g.K = 2048;
            pg8::StaticOrder so; so.init(g.M, g.N, (int)gridDim.x, (int)blockIdx.x);
            EpiIn e; e.U = P.u(); e.rstd = P.rstd();
            pg8::gemm_phase<EpiIn, pg8::StaticOrder>((PG8_LAS unsigned char*)smem, g, so, e);
            if (l + 1 < NLAYER && blockIdx.x >= 64 && gridDim.x > 64) { __syncthreads(); convert_weights(P, smem, (l + 1) * TILES_PER_LAYER, (l + 2) * TILES_PER_LAYER, (int)blockIdx.x - 64, (int)gridDim.x - 64); } }
        } else if (s == 1) { if (ONLY_S < 0 || ONLY_S == 1) phase2(P, l, smem); }
        else if (s == 2) { if (ONLY_S < 0 || ONLY_S == 2) phase3(P, l, smem, &s_item); }
        else if (s == 3) { if (ONLY_S < 0 || ONLY_S == 3) phase3b(P, l, smem); }
        else if (s == 5) { if (l + 1 < NLAYER) phase_rstd(P); }
        else if (ONLY_S < 0 || ONLY_S == 4) {
            pg8::Gemm g; g.A = P.y(); g.Bt = P.WoutT() + (size_t)l * 2048 * 2048; g.M = T_; g.N = 2048; g.K = 2048;
            pg8::StaticOrder so; so.init(g.M, g.N, (int)gridDim.x, (int)blockIdx.x);
            EpiOut e; e.xin = (l == 0) ? P.x : P.out; e.xout = P.out; e.xb = P.xb(); e.rsq = (l + 1 < NLAYER) ? P.rowsq() : nullptr;
#ifndef P4_STAGGER
#define P4_STAGGER 0
#endif
            if (P4_STAGGER > 0 && (blockIdx.x & 8)) { const unsigned long long w0 = wall_clock64(); while (wall_clock64() - w0 < (unsigned long long)P4_STAGGER) __builtin_amdgcn_s_sleep(8); }
            pg8::gemm_phase<EpiOut, pg8::StaticOrder>((PG8_LAS unsigned char*)smem, g, so, e);
        }
#ifdef PROBE_S
        if (s == PROBE_S) { cg::this_grid().sync(); const unsigned long long pt1 = wall_clock64(); while (wall_clock64() - pt1 < pt1 - pt0) __builtin_amdgcn_s_sleep(8); }
#endif
    }
}

extern "C" void kernel_launch(void* const* d_in, const int* in_sizes, int n_in, void* d_out, int out_size, void* d_ws, size_t ws_size, hipStream_t stream) {
    (void)in_sizes; (void)n_in; (void)out_size;
    Params p{};
    p.x = (const float*)d_in[0]; p.pos = (const int*)d_in[1]; p.ln_g = (const float*)d_in[2]; p.w_in = (const float*)d_in[3]; p.w_out = (const float*)d_in[4];
    p.gw2 = (const float*)d_in[5]; p.gb = (const float*)d_in[6]; p.gng = (const float*)d_in[7]; p.cw = (const float*)d_in[8]; p.cb = (const float*)d_in[9];
    p.dtb = (const float*)d_in[10]; p.alog = (const float*)d_in[11]; p.sD = (const float*)d_in[12]; p.sng = (const float*)d_in[13]; p.qng = (const float*)d_in[14];
    p.kvng = (const float*)d_in[15]; p.wuq = (const float*)d_in[16]; p.wukv = (const float*)d_in[17]; p.qhg = (const float*)d_in[18]; p.khg = (const float*)d_in[19];
    p.dqg = (const float*)d_in[20]; p.dkg = (const float*)d_in[21];
    p.out = (float*)d_out;
    p.ws = (unsigned char*)d_ws;
    if (WS_TOTAL > ws_size) { fprintf(stderr, "workspace too small: need %zu have %zu\n", (size_t)WS_TOTAL, ws_size); return; }
    static bool attr = false;
    if (!attr) { hipFuncSetAttribute((const void*)mk_fwd, hipFuncAttributeMaxDynamicSharedMemorySize, LDS_BYTES); attr = true; }
    const int NPH = 6 * NLAYER;
#if MK_MULTI
    for (int ph = 0; ph < NPH; ++ph) { p.ph_lo = ph; p.ph_hi = ph; hipLaunchKernelGGL(mk_fwd, dim3(256), dim3(512), LDS_BYTES, stream, p); }
#else
    static int grid_blocks = 0;
    if (!grid_blocks) { int dev = 0, cus = 0, per_cu = 0; hipGetDevice(&dev); hipDeviceGetAttribute(&cus, hipDeviceAttributeMultiprocessorCount, dev);
        hipOccupancyMaxActiveBlocksPerMultiprocessor(&per_cu, mk_fwd, 512, LDS_BYTES); if (per_cu < 1) per_cu = 1; if (per_cu > 1) per_cu = 1; grid_blocks = cus * per_cu; }
    p.ph_lo = 0; p.ph_hi = NPH - 1;
    (void)hipMemsetAsync((unsigned char*)d_ws + OFF_ctr + 256, 0, (size_t)XCD_BAR_WORDS * 4, stream);
    void* args[] = {&p};
    hipError_t e = hipLaunchCooperativeKernel((void*)mk_fwd, dim3(grid_blocks), dim3(512), args, LDS_BYTES, stream);
    if (e != hipSuccess) fprintf(stderr, "cooperative launch failed: %s (grid %d)\n", hipGetErrorString(e), grid_blocks);
#endif
}
```
